# Optimizing an MI355X kernel written in HIP

```python
import jax
import jax.numpy as jnp
from jax import lax
import numpy as np

D_MODEL = 1024
BATCH = 32
SEQ = 2048
DEPTH = 2

GRID_W = 64
CTX_LEN = 256
MIX_W = D_MODEL
N_MIXERS = 4
GROUP_W = MIX_W // N_MIXERS
HEAD_DIM = 64
N_Q_HEADS = GROUP_W // HEAD_DIM
N_KV_HEADS = N_Q_HEADS // 2
WINDOW = 128
ATT_BLOCK = WINDOW
ROPE_BASE = 10000.0
CONV_WIDTH = 31
CHUNK = 128
GMLP_HEADS = 4
GMLP_HEAD_W = GROUP_W // GMLP_HEADS
POOL_WINDOWS = (2, 4, 8, 16)
POOL_GROUP_W = GROUP_W // len(POOL_WINDOWS)
N_EXPERTS = 32
TOP_K = 4
D_FF = D_MODEL
SWIGLU_ALPHA = 1.702
SWIGLU_LIMIT = 7.0
MOE_BLOCK = 256
EPS = 1e-6
NEG_INF = -1e30

OFF_Q = 0
OFF_K = OFF_Q + N_Q_HEADS * HEAD_DIM
OFF_V = OFF_K + N_KV_HEADS * HEAD_DIM
OFF_CONV = OFF_V + N_KV_HEADS * HEAD_DIM
OFF_GMLP = OFF_CONV + 2 * GROUP_W
OFF_POOL = OFF_GMLP + 2 * GROUP_W
IN_W = OFF_POOL + GROUP_W

kernel_name = 'hybrid_parallel_dit_block'


def rmsnorm(x, g):
    xf = x.astype(jnp.float32)
    y = xf * lax.rsqrt(jnp.mean(xf * xf, axis=-1, keepdims=True) + EPS)
    return (y * g.astype(jnp.float32)).astype(x.dtype)


def layernorm(x, g, b):
    xf = x.astype(jnp.float32)
    mu = jnp.mean(xf, axis=-1, keepdims=True)
    xc = xf - mu
    y = xc * lax.rsqrt(jnp.mean(xc * xc, axis=-1, keepdims=True) + EPS)
    return (y * g.astype(jnp.float32) + b.astype(jnp.float32)).astype(x.dtype)


def group_rmsnorm(y, g):
    shp = y.shape
    yg = y.reshape(shp[:-1] + (N_MIXERS, GROUP_W))
    return rmsnorm(yg, g.reshape(N_MIXERS, GROUP_W)).reshape(shp)


def adaln(cond, w, b):
    m = jax.nn.silu(cond) @ w + b
    return m.reshape(m.shape[:-1] + (6, D_MODEL))


def axial_rope_tables(L):
    rows = L // GRID_W
    t = jnp.arange(rows * GRID_W)
    row = (t // GRID_W).astype(jnp.float32)
    col = (t % GRID_W).astype(jnp.float32)
    half = HEAD_DIM // 2
    inv = ROPE_BASE ** (-jnp.arange(0, half, 2, dtype=jnp.float32) / half)
    ang_r = row[:, None] * inv[None, :]
    ang_c = col[:, None] * inv[None, :]
    return (jnp.cos(ang_r), jnp.sin(ang_r), jnp.cos(ang_c), jnp.sin(ang_c))


def rotate(x, cos, sin):
    cs = cos[:, None, :].astype(x.dtype)
    sn = sin[:, None, :].astype(x.dtype)
    x1, x2 = jnp.split(x, 2, axis=-1)
    return jnp.concatenate([x1 * cs - x2 * sn, x2 * cs + x1 * sn], axis=-1)


def apply_axial_rope(x, tabs):
    cos_r, sin_r, cos_c, sin_c = tabs
    half = HEAD_DIM // 2
    return jnp.concatenate([rotate(x[..., :half], cos_r, sin_r),
                            rotate(x[..., half:], cos_c, sin_c)], axis=-1)


def window_attention(q, k, v, kc, vc, sink):
    b, L = q.shape[0], q.shape[1]
    nb = L // ATT_BLOCK
    grp = N_Q_HEADS // N_KV_HEADS
    scale = HEAD_DIM ** -0.5
    qb = q.reshape(b, nb, ATT_BLOCK, N_KV_HEADS, grp, HEAD_DIM)

    def band(t):
        tp = jnp.pad(t, ((0, 0), (ATT_BLOCK, ATT_BLOCK), (0, 0), (0, 0)))
        tp = tp.reshape(b, nb + 2, ATT_BLOCK, N_KV_HEADS, HEAD_DIM)
        return jnp.concatenate([tp[:, :-2], tp[:, 1:-1], tp[:, 2:]], axis=2)

    kw = band(k)
    vw = band(v)
    s_loc = jnp.einsum('bnqkgd,bnjkd->bnkgqj', qb, kw).astype(jnp.float32) * scale
    s_ctx = jnp.einsum('bnqkgd,bckd->bnkgqc', qb, kc).astype(jnp.float32) * scale
    qi = jnp.arange(ATT_BLOCK)[:, None]
    kj = jnp.arange(3 * ATT_BLOCK)[None, :]
    in_band = (kj >= qi) & (kj <= qi + 2 * WINDOW)
    key_pos = (jnp.arange(nb)[:, None] - 1) * ATT_BLOCK + jnp.arange(3 * ATT_BLOCK)[None, :]
    in_seq = (key_pos >= 0) & (key_pos < L)
    mask = in_band[None, :, :] & in_seq[:, None, :]
    s_loc = jnp.where(mask[None, :, None, None], s_loc, NEG_INF)
    s_sink = jnp.broadcast_to(
        sink.astype(jnp.float32).reshape(N_KV_HEADS, grp)[None, None, :, :, None, None],
        s_loc.shape[:-1] + (1,))
    p = jax.nn.softmax(jnp.concatenate([s_sink, s_ctx, s_loc], axis=-1), axis=-1).astype(q.dtype)
    lc = kc.shape[1]
    o = (jnp.einsum('bnkgqc,bckd->bnqkgd', p[..., 1:1 + lc], vc)
         + jnp.einsum('bnkgqj,bnjkd->bnqkgd', p[..., 1 + lc:], vw))
    return o.reshape(b, L, N_Q_HEADS * HEAD_DIM)


def ctx_attention(qc, kc, vc, sink):
    b, lc = qc.shape[0], qc.shape[1]
    grp = N_Q_HEADS // N_KV_HEADS
    scale = HEAD_DIM ** -0.5
    qg = qc.reshape(b, lc, N_KV_HEADS, grp, HEAD_DIM)
    s = jnp.einsum('bqkgd,bckd->bkgqc', qg, kc).astype(jnp.float32) * scale
    s_sink = jnp.broadcast_to(
        sink.astype(jnp.float32).reshape(N_KV_HEADS, grp)[None, :, :, None, None],
        s.shape[:-1] + (1,))
    p = jax.nn.softmax(jnp.concatenate([s_sink, s], axis=-1), axis=-1).astype(qc.dtype)
    o = jnp.einsum('bkgqc,bckd->bqkgd', p[..., 1:], vc)
    return o.reshape(b, lc, N_Q_HEADS * HEAD_DIM)


def conformer_conv(h2, dw_w, dw_b, ln_g, ln_b, pw):
    a, gte = jnp.split(h2, 2, axis=-1)
    h = a * jax.nn.sigmoid(gte)
    h = lax.conv_general_dilated(
        h, dw_w[:, None, :], window_strides=(1,),
        padding=[(CONV_WIDTH // 2, CONV_WIDTH // 2)],
        dimension_numbers=('NWC', 'WIO', 'NWC'),
        feature_group_count=GROUP_W) + dw_b
    h = jax.nn.silu(layernorm(h, ln_g, ln_b))
    return h @ pw


def chunk_gating(h2, ln_g, ln_b, ws, bs):
    u, v = jnp.split(h2, 2, axis=-1)
    v = layernorm(v, ln_g, ln_b)
    b, L = v.shape[0], v.shape[1]
    nc = L // CHUNK
    vr = v.reshape(b, nc, CHUNK, GMLP_HEADS, GMLP_HEAD_W)
    mixed = jnp.einsum('hpq,bnqhc->bnphc', ws, vr) + bs.T[None, None, :, :, None]
    return u * mixed.reshape(b, L, GROUP_W)


def pool_mix(h, pw, pscale):
    b, L = h.shape[0], h.shape[1]
    hf = h.astype(jnp.float32)
    csum = jnp.concatenate([jnp.zeros((b, 1, GROUP_W), jnp.float32), jnp.cumsum(hf, axis=1)], axis=1)
    t = jnp.arange(L)
    outs = []
    for gi, w in enumerate(POOL_WINDOWS):
        lo = jnp.clip(t - w // 2, 0, L)
        hi = jnp.clip(t + w // 2, 0, L)
        sl = slice(gi * POOL_GROUP_W, (gi + 1) * POOL_GROUP_W)
        cs = csum[..., sl]
        mean = (cs[:, hi] - cs[:, lo]) / (hi - lo).astype(jnp.float32)[:, None]
        y = (mean - hf[..., sl]).astype(h.dtype)
        outs.append(y @ pw[gi])
    return jnp.concatenate(outs, axis=-1) * pscale


def local_mixers(p, dw_w, dw_b, cln_g, cln_b, cpw, gln_g, gln_b, gws, gbs, pw, ps):
    conv = conformer_conv(p[..., OFF_CONV:OFF_GMLP], dw_w, dw_b, cln_g, cln_b, cpw)
    gm = chunk_gating(p[..., OFF_GMLP:OFF_POOL], gln_g, gln_b, gws, gbs)
    pl = pool_mix(p[..., OFF_POOL:IN_W], pw, ps)
    return jnp.concatenate([conv, gm, pl], axis=-1)


def merge_heads(att, local, gn_g, wo):
    return group_rmsnorm(jnp.concatenate([att, local], axis=-1), gn_g) @ wo


def clamped_swiglu(h):
    glu, lin = jnp.split(h, 2, axis=-1)
    glu = jnp.minimum(glu, SWIGLU_LIMIT)
    lin = jnp.clip(lin, -SWIGLU_LIMIT, SWIGLU_LIMIT)
    return glu * jax.nn.sigmoid(SWIGLU_ALPHA * glu) * (lin + 1.0)


def moe(h, rw, rb, w1, b1, w2, b2):
    n_tok, d = h.shape
    logits = (h @ rw + rb).astype(jnp.float32)
    top_val, top_idx = lax.top_k(logits, TOP_K)
    gates = jax.nn.softmax(top_val, axis=-1)
    n_asg = n_tok * TOP_K
    flat_e = top_idx.reshape(-1)
    order = jnp.argsort(flat_e)
    sorted_e = flat_e[order]
    src_tok = order // TOP_K
    counts = jnp.bincount(flat_e, length=N_EXPERTS)
    padded = (counts + MOE_BLOCK - 1) // MOE_BLOCK * MOE_BLOCK
    pad_end = jnp.cumsum(padded)
    pad_start = pad_end - padded
    start = jnp.cumsum(counts) - counts
    dest = pad_start[sorted_e] + jnp.arange(n_asg) - start[sorted_e]
    n_rows = -(-n_asg // MOE_BLOCK) * MOE_BLOCK + N_EXPERTS * MOE_BLOCK
    n_blk = n_rows // MOE_BLOCK
    row_tok = jnp.zeros((n_rows,), jnp.int32).at[dest].set(src_tok.astype(jnp.int32))
    row_w = jnp.zeros((n_rows,), h.dtype).at[dest].set(gates.reshape(-1)[order].astype(h.dtype))
    blk_e = jnp.minimum(jnp.searchsorted(pad_end, jnp.arange(n_blk) * MOE_BLOCK, side='right'),
                        N_EXPERTS - 1)
    xp = h[row_tok].reshape(n_blk, MOE_BLOCK, d)

    def run_block(args):
        xb, e = args
        return clamped_swiglu(xb @ w1[e] + b1[e]) @ w2[e] + b2[e]

    yp = lax.map(run_block, (xp, blk_e)).reshape(n_rows, d)
    return jax.ops.segment_sum(yp * row_w[:, None], row_tok, num_segments=n_tok)


def setup_inputs(seed: int = 0) -> dict:
    key = jax.random.key(seed)
    ks = jax.random.split(key, 32)

    def nrm(k, shape, scale):
        return jax.random.normal(k, shape, jnp.float32) * scale

    D = D_MODEL
    return {
        'x': nrm(ks[0], (BATCH, SEQ, D), 1.0),
        'c': nrm(ks[1], (BATCH, D), 1.0),
        'ctx': nrm(ks[2], (BATCH, CTX_LEN, D), 1.0),
        'c_ctx': nrm(ks[3], (D,), 1.0),
        'ada_w': nrm(ks[4], (DEPTH, D, 6 * D), 0.5 * D ** -0.5),
        'ada_b': nrm(ks[5], (DEPTH, 6 * D), 0.02),
        'norm1_g': 1.0 + nrm(ks[6], (DEPTH, D), 0.05),
        'norm2_g': 1.0 + nrm(ks[7], (DEPTH, D), 0.05),
        'w_in': nrm(ks[8], (DEPTH, D, IN_W), D ** -0.5),
        'attn_sink': nrm(ks[9], (DEPTH, N_Q_HEADS), 1.0),
        'conv_dw_w': nrm(ks[10], (DEPTH, CONV_WIDTH, GROUP_W), CONV_WIDTH ** -0.5),
        'conv_dw_b': nrm(ks[11], (DEPTH, GROUP_W), 0.02),
        'conv_ln_g': 1.0 + nrm(ks[12], (DEPTH, GROUP_W), 0.05),
        'conv_ln_b': nrm(ks[13], (DEPTH, GROUP_W), 0.02),
        'conv_pw_w': nrm(ks[14], (DEPTH, GROUP_W, GROUP_W), GROUP_W ** -0.5),
        'gmlp_ln_g': 1.0 + nrm(ks[15], (DEPTH, GROUP_W), 0.05),
        'gmlp_ln_b': nrm(ks[16], (DEPTH, GROUP_W), 0.02),
        'gmlp_ws': nrm(ks[17], (DEPTH, GMLP_HEADS, CHUNK, CHUNK), CHUNK ** -0.5),
        'gmlp_bs': 1.0 + nrm(ks[18], (DEPTH, GMLP_HEADS, CHUNK), 0.02),
        'pool_w': nrm(ks[19], (DEPTH, len(POOL_WINDOWS), POOL_GROUP_W, POOL_GROUP_W), POOL_GROUP_W ** -0.5),
        'pool_scale': 1.0 + nrm(ks[20], (DEPTH, GROUP_W), 0.05),
        'group_norm_g': 1.0 + nrm(ks[21], (DEPTH, MIX_W), 0.05),
        'w_out': nrm(ks[22], (DEPTH, MIX_W, D), MIX_W ** -0.5),
        'router_w': nrm(ks[23], (DEPTH, D, N_EXPERTS), D ** -0.5),
        'router_b': nrm(ks[24], (DEPTH, N_EXPERTS), 0.01),
        'exp_w1': nrm(ks[25], (DEPTH, N_EXPERTS, D, 2 * D_FF), D ** -0.5),
        'exp_b1': nrm(ks[26], (DEPTH, N_EXPERTS, 2 * D_FF), 0.02),
        'exp_w2': nrm(ks[27], (DEPTH, N_EXPERTS, D_FF, D), D_FF ** -0.5),
        'exp_b2': nrm(ks[28], (DEPTH, N_EXPERTS, D), 0.02),
        'final_norm_g': 1.0 + nrm(ks[29], (D,), 0.05),
    }


def reference(x, c, ctx, c_ctx, ada_w, ada_b, norm1_g, norm2_g, w_in, attn_sink,
              conv_dw_w, conv_dw_b, conv_ln_g, conv_ln_b, conv_pw_w,
              gmlp_ln_g, gmlp_ln_b, gmlp_ws, gmlp_bs, pool_w, pool_scale,
              group_norm_g, w_out, router_w, router_b, exp_w1, exp_b1, exp_w2, exp_b2,
              final_norm_g):
    b, L, d = x.shape
    lc = ctx.shape[1]
    kv_w = N_KV_HEADS * HEAD_DIM
    tabs = axial_rope_tables(L)
    for l in range(DEPTH):
        last = l == DEPTH - 1
        mx = adaln(c, ada_w[l], ada_b[l])[:, :, None, :]
        sh1, sc1, g1, sh2, sc2, g2 = [mx[:, i] for i in range(6)]
        mc = adaln(c_ctx, ada_w[l], ada_b[l])
        sh1c, sc1c, g1c, sh2c, sc2c, g2c = [mc[i] for i in range(6)]
        lp = (conv_dw_w[l], conv_dw_b[l], conv_ln_g[l], conv_ln_b[l], conv_pw_w[l],
              gmlp_ln_g[l], gmlp_ln_b[l], gmlp_ws[l], gmlp_bs[l], pool_w[l], pool_scale[l])

        hx = rmsnorm(x, norm1_g[l]) * (1.0 + sc1) + sh1
        hc = rmsnorm(ctx, norm1_g[l]) * (1.0 + sc1c) + sh1c
        px = hx @ w_in[l]
        if last:
            kvc = hc @ w_in[l][:, OFF_K:OFF_CONV]
        else:
            pc = hc @ w_in[l]
            kvc = pc[..., OFF_K:OFF_CONV]
        kc = kvc[..., :kv_w].reshape(b, lc, N_KV_HEADS, HEAD_DIM)
        vc = kvc[..., kv_w:].reshape(b, lc, N_KV_HEADS, HEAD_DIM)

        q = apply_axial_rope(px[..., OFF_Q:OFF_K].reshape(b, L, N_Q_HEADS, HEAD_DIM), tabs)
        k = apply_axial_rope(px[..., OFF_K:OFF_V].reshape(b, L, N_KV_HEADS, HEAD_DIM), tabs)
        v = px[..., OFF_V:OFF_CONV].reshape(b, L, N_KV_HEADS, HEAD_DIM)
        att_x = window_attention(q, k, v, kc, vc, attn_sink[l])
        x = x + g1 * merge_heads(att_x, local_mixers(px, *lp), group_norm_g[l], w_out[l])
        if not last:
            qc = pc[..., OFF_Q:OFF_K].reshape(b, lc, N_Q_HEADS, HEAD_DIM)
            att_c = ctx_attention(qc, kc, vc, attn_sink[l])
            ctx = ctx + g1c * merge_heads(att_c, local_mixers(pc, *lp), group_norm_g[l], w_out[l])

        h2x = (rmsnorm(x, norm2_g[l]) * (1.0 + sc2) + sh2).reshape(b * L, d)
        if last:
            ff = moe(h2x, router_w[l], router_b[l], exp_w1[l], exp_b1[l], exp_w2[l], exp_b2[l])
            x = x + g2 * ff.reshape(b, L, d)
        else:
            h2c = (rmsnorm(ctx, norm2_g[l]) * (1.0 + sc2c) + sh2c).reshape(b * lc, d)
            ff = moe(jnp.concatenate([h2x, h2c], axis=0), router_w[l], router_b[l],
                     exp_w1[l], exp_b1[l], exp_w2[l], exp_b2[l])
            x = x + g2 * ff[:b * L].reshape(b, L, d)
            ctx = ctx + g2c * ff[b * L:].reshape(b, lc, d)
    return rmsnorm(x, final_norm_g)
```

```cpp
#include <hip/hip_runtime.h>
#include <cstdio>
#include <cstdint>

#define DBG_SKIP_MOE 0
#define DBG_CHECK 0
#ifndef MK_LAUNCH_PER_PHASE
#define MK_LAUNCH_PER_PHASE 0
#endif

#define GAS __attribute__((address_space(1)))
#define LAS __attribute__((address_space(3)))
typedef unsigned short bf16;
typedef unsigned v4u __attribute__((ext_vector_type(4)));
typedef unsigned v2u __attribute__((ext_vector_type(2)));
typedef float f32x4 __attribute__((ext_vector_type(4)));
typedef float f32x2 __attribute__((ext_vector_type(2)));
typedef short bf16x8 __attribute__((ext_vector_type(8)));

constexpr int D = 1024, NBATCH = 32, SEQ = 2048, CTXL = 256;
constexpr int TX = NBATCH * SEQ, TC = NBATCH * CTXL, TT = TX + TC;
constexpr int INW = 1792, NEXP = 32;
constexpr int OFF_K = 256, OFF_V = 384, OFF_CONV = 512, OFF_GMLP = 1024, OFF_POOL = 1536;
constexpr float EPS = 1e-6f;
constexpr int MAXROWS = 303104;
#ifndef DBG_CHECK
#define DBG_CHECK 0
#endif
constexpr int NPHASE = DBG_CHECK ? 21 : 20;

constexpr size_t MiB = 1ull << 20;
constexpr size_t WS_CTL = 0, CTL_ZERO_BYTES = 1 * MiB;
constexpr size_t WS_MOD = 1 * MiB;
constexpr size_t WS_ROPE = 3 * MiB;
constexpr size_t WS_META = 3 * MiB + 65536;
constexpr size_t WS_GWSB = 4 * MiB;
constexpr size_t WS_CPWT = 4 * MiB + 256 * 1024;
constexpr size_t WS_PWT = 4 * MiB + 512 * 1024;
constexpr size_t WS_WIN = 5 * MiB;
constexpr size_t WS_WOUT = 12 * MiB;
constexpr size_t WS_W1 = 16 * MiB;
constexpr size_t WS_W2 = 272 * MiB;
constexpr size_t WS_CTXR = 400 * MiB;
constexpr size_t WS_ROUTE = 432 * MiB;
constexpr size_t WS_HX = 440 * MiB;
constexpr size_t WS_R1 = 584 * MiB;
constexpr size_t WS_R2 = 1176 * MiB;
constexpr size_t WS_BMF = 1768 * MiB;
constexpr size_t WS_CVEC = WS_MOD + 1792 * 1024;
constexpr size_t WS_XB = 1784 * MiB;
constexpr size_t WS_END = 1912 * MiB;
constexpr size_t RT_TOPI = 0, RT_GATE = 1280 * 1024, RT_LPOS = 2560 * 1024, RT_SLOT = 3840 * 1024, RT_ROWTOK = 5 * MiB, RT_WVCNT = 6 * MiB + 512 * 1024;
constexpr int CW_BAR = 4096;

constexpr int RING_BYTES = 131072;
constexpr int MISC_OFF = RING_BYTES;
constexpr int LDS_BYTES = 147456;
constexpr int MO_BAR = 0;
constexpr int MO_PS = 256;
constexpr int MO_PT = 512;
constexpr int MO_TILEE = 1024;
constexpr int MO_ROWTAB = 12288;
constexpr int MO_TMP = 4096;

__device__ __forceinline__ int tidx_(int w0) { int t; asm volatile("v_mbcnt_lo_u32_b32 %0, -1, 0\n\tv_mbcnt_hi_u32_b32 %0, -1, %0" : "=v"(t)); return (w0 << 6) | t; }
#define TIDX(w0) tidx_(w0)
__device__ __forceinline__ int opq(int v) { asm volatile("" : "+s"(v)); return v; }
__device__ __forceinline__ int bidx_() { int b = blockIdx.x; asm volatile("" : "+s"(b)); return b; }
__device__ __forceinline__ int gdim_() { int g = gridDim.x; asm volatile("" : "+s"(g)); return g; }
typedef float f32x2c_ __attribute__((ext_vector_type(2)));
typedef __bf16 bf16x2c_ __attribute__((ext_vector_type(2)));
__device__ __forceinline__ unsigned pk2(float lo, float hi) { const f32x2c_ v = {lo, hi}; const bf16x2c_ b = __builtin_convertvector(v, bf16x2c_); return __builtin_bit_cast(unsigned, b); }
__device__ __forceinline__ unsigned f2bf(float f) { return pk2(f, 0.f) & 0xffffu; }
__device__ __forceinline__ float bflo(unsigned w) { return __builtin_bit_cast(float, w << 16); }
__device__ __forceinline__ float bfhi(unsigned w) { return __builtin_bit_cast(float, w & 0xffff0000u); }
__device__ __forceinline__ float bf1(bf16 h) { return __builtin_bit_cast(float, ((unsigned)h) << 16); }
__device__ __forceinline__ unsigned cvt_pk_bf16(float lo, float hi) { return pk2(lo, hi); }
template <int CTRL> __device__ __forceinline__ float dpp_f(float v) { return __int_as_float(__builtin_amdgcn_mov_dpp(__float_as_int(v), CTRL, 0xf, 0xf, true)); }
template <int CTRL> __device__ __forceinline__ int dpp_i(int v) { return __builtin_amdgcn_mov_dpp(v, CTRL, 0xf, 0xf, true); }
__device__ __forceinline__ float wave_sum(float v) {
    v += dpp_f<0xB1>(v); v += dpp_f<0x4E>(v); v += dpp_f<0x124>(v); v += dpp_f<0x128>(v);
    const float a = __int_as_float(__builtin_amdgcn_readlane(__float_as_int(v), 0)), b = __int_as_float(__builtin_amdgcn_readlane(__float_as_int(v), 16));
    const float c = __int_as_float(__builtin_amdgcn_readlane(__float_as_int(v), 32)), d = __int_as_float(__builtin_amdgcn_readlane(__float_as_int(v), 48));
    return (a + b) + (c + d);
}
__device__ __forceinline__ float xor32_sum(float v) { const auto rr = __builtin_amdgcn_permlane32_swap(__float_as_uint(v), __float_as_uint(v), false, false); return __uint_as_float(rr[0]) + __uint_as_float(rr[1]); }
__device__ __forceinline__ float xor32_max(float v) { const auto rr = __builtin_amdgcn_permlane32_swap(__float_as_uint(v), __float_as_uint(v), false, false); return fmaxf(__uint_as_float(rr[0]), __uint_as_float(rr[1])); }
__device__ __forceinline__ float xor16_sum(float v) { const auto rr = __builtin_amdgcn_permlane16_swap(__float_as_uint(v), __float_as_uint(v), false, false); return __uint_as_float(rr[0]) + __uint_as_float(rr[1]); }
__device__ __forceinline__ float xor32_other(float v, bool upper) { const auto rr = __builtin_amdgcn_permlane32_swap(__float_as_uint(v), __float_as_uint(v), false, false); return upper ? __uint_as_float(rr[0]) : __uint_as_float(rr[1]); }
__device__ __forceinline__ float sigmoidf_(float x) { return __builtin_amdgcn_rcpf(1.0f + __builtin_amdgcn_exp2f(-1.4426950408889634f * x)); }
#define LDS_WAIT() asm volatile("s_waitcnt lgkmcnt(0)" ::: "memory")
#define VM_WAIT() asm volatile("s_waitcnt vmcnt(0)" ::: "memory")

#define XB_TMO      128
#define XB_XCNT(j)  (256  + 64 * (j))
#define XB_XSUB(j)  (1280 + 64 * (j))
#define XB_XGEN(j)  (2304 + 64 * (j))
#define XB_TOP      3328
#define XB_TOPGEN   3392
#define XCD_BAR_WORDS 3456
#define XB_SPIN_CAP (1u << 18)
__device__ __forceinline__ unsigned xb_ld(GAS unsigned* p)              { return __hip_atomic_load(p, __ATOMIC_RELAXED, __HIP_MEMORY_SCOPE_AGENT); }
__device__ __forceinline__ unsigned xb_add(GAS unsigned* p, unsigned v) { return __hip_atomic_fetch_add(p, v, __ATOMIC_RELAXED, __HIP_MEMORY_SCOPE_AGENT); }
__device__ __forceinline__ unsigned xb_xcc_id() { return (unsigned)__builtin_amdgcn_s_getreg((3 << 11) | 20) & 0xFu; }
#define XB_SPIN(cond, bar) do { unsigned _sp = 0; while (cond) { __builtin_amdgcn_s_sleep(1); \
    if ((++_sp & 255u) == 0u) { if (xb_ld(&(bar)[XB_TMO])) break; if (_sp > XB_SPIN_CAP) { __hip_atomic_fetch_add(&(bar)[XB_TMO], 1u, __ATOMIC_RELAXED, __HIP_MEMORY_SCOPE_AGENT); break; } } } } while (0)
struct XcdBarrier { GAS unsigned* bar; unsigned x; volatile LAS unsigned* st; };
__device__ __forceinline__ XcdBarrier xcd_barrier_post(GAS unsigned* bar, volatile LAS unsigned* st, int w0) {
    XcdBarrier b; b.bar = bar; b.x = xb_xcc_id(); b.st = st;
    if (TIDX(w0) == 0) (void)xb_add(&bar[XB_XCNT(b.x)], 1u);
    return b;
}
__device__ __forceinline__ void xcd_barrier_complete(GAS unsigned* bar, unsigned x, unsigned& nloc, unsigned& nx) {
    const unsigned G = gridDim.x * gridDim.y * gridDim.z;
    unsigned sum, cnt, mine, sp = 0u;
    for (;;) {
        sum = 0u; cnt = 0u; mine = 0u;
#pragma unroll
        for (unsigned j = 0; j < 16; ++j) { const unsigned c = xb_ld(&bar[XB_XCNT(j)]); sum += c; cnt += (c > 0u) ? 1u : 0u; mine = (j == x) ? c : mine; }
        if (sum == G) break;
        __builtin_amdgcn_s_sleep(1);
        if ((++sp & 255u) == 0u) { if (xb_ld(&bar[XB_TMO])) break; if (sp > XB_SPIN_CAP) { __hip_atomic_fetch_add(&bar[XB_TMO], 1u, __ATOMIC_RELAXED, __HIP_MEMORY_SCOPE_AGENT); break; } }
    }
    nloc = mine > 0u ? mine : 1u; nx = cnt > 0u ? cnt : 1u;
}
__device__ __forceinline__ void xcd_barrier(const XcdBarrier& b0, int w0) {
    asm volatile("s_waitcnt vmcnt(0)" ::: "memory");
    __syncthreads();
    if (TIDX(w0) == 0) {
        XcdBarrier b; { unsigned long long bp = (unsigned long long)b0.bar; asm volatile("" : "+s"(bp)); b.bar = (GAS unsigned*)bp; b.x = (unsigned)opq((int)b0.x); b.st = b0.st; }
        GAS unsigned* bar = b.bar;
        __builtin_amdgcn_s_waitcnt(0);
        unsigned nloc = b.st[0], nx = b.st[1];
        if (nloc == 0u) { xcd_barrier_complete(bar, b.x, nloc, nx); b.st[0] = nloc; b.st[1] = nx; }
        const unsigned old = xb_add(&bar[XB_XSUB(b.x)], 1u);
        const unsigned gen = old / nloc;
        if (old + 1u == (gen + 1u) * nloc) {
            __builtin_amdgcn_fence(__ATOMIC_RELEASE, "agent");
            asm volatile("s_waitcnt vmcnt(0)" ::: "memory");
            const unsigned og = xb_add(&bar[XB_TOP], 1u);
            const unsigned tg = og / nx;
            if (og + 1u == (tg + 1u) * nx) xb_add(&bar[XB_TOPGEN], 1u);
            else XB_SPIN(xb_ld(&bar[XB_TOPGEN]) == tg, bar);
            __builtin_amdgcn_fence(__ATOMIC_ACQUIRE, "agent");
            xb_add(&bar[XB_XGEN(b.x)], 1u);
            asm volatile("s_waitcnt vmcnt(0)" ::: "memory");
        } else {
            XB_SPIN(xb_ld(&bar[XB_XGEN(b.x)]) == gen, bar);
            __builtin_amdgcn_fence(__ATOMIC_ACQUIRE, "agent");
            asm volatile("s_waitcnt vmcnt(0)" ::: "memory");
        }
    }
    __syncthreads();
}

namespace pg8 {
constexpr int BM = 256, BK = 64, HALF = 128, HTB = HALF * BK * 2, STAGE_BYTES = 8 * HTB;
__host__ __device__ __forceinline__ int lds_byte(int r, int c) { const int st = (r >> 4) * 2 + (c >> 5), rr = r & 15, cc = c & 31, ob = rr * 64 + cc * 2; return st * 1024 + (ob ^ (((ob >> 9) & 1) << 5)); }
__host__ __device__ __forceinline__ void stage_rc(int b, int& R, int& C) { const int st = b / 1024, sb = b % 1024, swz = sb ^ (((sb >> 9) & 1) << 5); R = (st >> 1) * 16 + swz / 64; C = (st & 1) * 32 + (swz % 64) / 2; }
__host__ __device__ __forceinline__ int perm32(int rho) { const int n = rho >> 4, i = rho & 15; return 8 * (i >> 2) + 4 * n + (i & 3); }
struct Unit { int pm, pn, e; };
typedef int v8i __attribute__((ext_vector_type(8)));
typedef int v4i_ __attribute__((ext_vector_type(4)));
__device__ __forceinline__ v8i cat8(bf16x8 a, bf16x8 b) { return __builtin_shufflevector(__builtin_bit_cast(v4i_, a), __builtin_bit_cast(v4i_, b), 0, 1, 2, 3, 4, 5, 6, 7); }

template <class P>
__device__ __forceinline__ void gemm_phase(LAS unsigned char* lds, const P& S, const int w0_) {
    const int w0 = opq(w0_);
    const int tid = TIDX(w0), wid = w0, lane = tid & 63, wr = wid >> 2, wc = wid & 3, fr = lane & 15, fq = lane >> 4;
    constexpr int K = P::K; constexpr bool F8 = P::FP8, GA = P::GATHER; constexpr int ROWB = F8 ? K : 2 * K, nt = ROWB / 128;
    unsigned voffA[2], voffB[2]; int R0 = 0, C0 = 0;
#pragma unroll
    for (int i = 0; i < 2; ++i) { int R, C; stage_rc(tid * 16 + i * 8192, R, C); const int Rb = P::PERM ? ((R & ~31) + perm32(R & 31)) : R; if (i == 0) { R0 = R; C0 = C; }
        voffA[i] = (unsigned)(R * ROWB + 2 * C); voffB[i] = (unsigned)(Rb * ROWB + 2 * C); }
    const unsigned kstep = 128u, hstep = (unsigned)(HALF * ROWB), hstepB = S.b_hstep();
    const __amdgpu_buffer_rsrc_t rsA = __builtin_amdgcn_make_buffer_rsrc((void*)S.a_base(), 0, 0x7fffffff, 0x00020000);
    const __amdgpu_buffer_rsrc_t rsB = __builtin_amdgcn_make_buffer_rsrc((void*)S.b_base(), 0, 0x7fffffff, 0x00020000);
    const unsigned ldsw = (unsigned)wid * 1024u;
    int sc8 = 0x7F7F7F7F; asm volatile("" : "+v"(sc8));
    const int aoff = lds_byte(wr * 64 + fr, fq * 8), boff = lds_byte(wc * 32 + fr, fq * 8);
    unsigned offA[4] = {0u, 0u, 0u, 0u}, offN[4] = {0u, 0u, 0u, 0u};
    LAS unsigned char* rowtab = lds + MISC_OFF + MO_ROWTAB;
#define PG8_SA(b, h) (((b) * 2 + (h)) * HTB)
#define PG8_SB(b, h) ((4 + (b) * 2 + (h)) * HTB)
#define PG8_STAGE(bufoff, rs, soff, voff) do { _Pragma("unroll") for (int _i = 0; _i < 2; ++_i) \
        __builtin_amdgcn_raw_ptr_buffer_load_lds((rs), (LAS unsigned*)(lds + (bufoff) + ldsw + _i * 8192), 16, (voff)[_i], (soff), 0, 0); } while (0)
#define PG8_STAGEA(bufoff, h, ubase, oo, kb) do { if constexpr (GA) { _Pragma("unroll") for (int _i = 0; _i < 2; ++_i) \
        __builtin_amdgcn_raw_ptr_buffer_load_lds(rsA, (LAS unsigned*)(lds + (bufoff) + ldsw + _i * 8192), 16, (oo)[2 * (h) + _i], (kb), 0, 0); } \
        else { PG8_STAGE(bufoff, rsA, (ubase) + (h) * hstep + (kb), voffA); } } while (0)
#define PG8_LDA(dst, b, h) do { _Pragma("unroll") for (int m = 0; m < 4; ++m) _Pragma("unroll") for (int k = 0; k < 2; ++k) dst[m][k] = *(const LAS bf16x8*)(lds + PG8_SA(b, h) + aoff + m * 2048 + k * 1024); } while (0)
#define PG8_LDB(dst, b, h) do { _Pragma("unroll") for (int n = 0; n < 2; ++n) _Pragma("unroll") for (int k = 0; k < 2; ++k) dst[n][k] = *(const LAS bf16x8*)(lds + PG8_SB(b, h) + boff + n * 2048 + k * 1024); } while (0)
#define PG8_MMA(ai, bj, At, Bt) do { __builtin_amdgcn_s_setprio(1); \
        if constexpr (!F8) { _Pragma("unroll") for (int m = 0; m < 4; ++m) _Pragma("unroll") for (int n = 0; n < 2; ++n) _Pragma("unroll") for (int k = 0; k < 2; ++k) \
            acc[ai][bj][m][n] = __builtin_amdgcn_mfma_f32_16x16x32_bf16(Bt[n][k], At[m][k], acc[ai][bj][m][n], 0, 0, 0); } \
        else { _Pragma("unroll") for (int m = 0; m < 4; ++m) _Pragma("unroll") for (int n = 0; n < 2; ++n) \
            asm volatile("v_mfma_scale_f32_16x16x128_f8f6f4 %0, %1, %2, %0, %3, %3 op_sel_hi:[0,0,0]" : "+v"(acc[ai][bj][m][n]) : "v"(cat8(Bt[n][0], Bt[n][1])), "v"(cat8(At[m][0], At[m][1])), "v"(sc8)); } \
        __builtin_amdgcn_s_setprio(0); } while (0)
#define PG8_MMAZ(ai, bj, At, Bt) do { __builtin_amdgcn_s_setprio(1); \
        _Pragma("unroll") for (int m = 0; m < 4; ++m) _Pragma("unroll") for (int n = 0; n < 2; ++n) \
            asm volatile("v_mfma_scale_f32_16x16x128_f8f6f4 %0, %1, %2, 0, %3, %3 op_sel_hi:[0,0,0]" : "+v"(acc[ai][bj][m][n]) : "v"(cat8(Bt[n][0], Bt[n][1])), "v"(cat8(At[m][0], At[m][1])), "v"(sc8)); \
        __builtin_amdgcn_s_setprio(0); } while (0)
#define PG8_WAIT_V(n) asm volatile("s_waitcnt vmcnt(" #n ")" ::: "memory")
#define PG8_WAIT_L(n) asm volatile("s_waitcnt lgkmcnt(" #n ")" ::: "memory")
#define PG8_BAR __builtin_amdgcn_s_barrier()
#define PG8_SCHED __builtin_amdgcn_sched_barrier(0)
    Unit cur, nxt; int ui = 0;
    if (!S.next(0, cur)) return;
    f32x4 acc[2][2][4][2];
#pragma unroll
    for (int a = 0; a < 2; ++a)
#pragma unroll
        for (int b = 0; b < 2; ++b)
#pragma unroll
            for (int m = 0; m < 4; ++m)
#pragma unroll
                for (int n = 0; n < 2; ++n) acc[a][b][m][n] = (f32x4){0.f, 0.f, 0.f, 0.f};
    bf16x8 At[4][2], B0[2][2], B1[2][2];
    typename P::Pre pre = {};
    unsigned cA = GA ? 0u : S.a_off(cur), cB = S.b_off(cur);
    if constexpr (GA) {
        const GAS int* rt = S.rowtab_g() + cur.pm * 256 + R0;
#pragma unroll
        for (int j = 0; j < 4; ++j) offA[j] = (unsigned)rt[64 * j] * (unsigned)ROWB + (unsigned)(2 * C0);
#pragma unroll
        for (int j = 0; j < 4; ++j) offN[j] = offA[j];
    }
    PG8_STAGE(PG8_SB(0, 0), rsB, cB, voffB); PG8_STAGE(PG8_SB(0, 1), rsB, cB + hstepB, voffB); PG8_STAGEA(PG8_SA(0, 0), 0, cA, offA, 0u); PG8_STAGEA(PG8_SA(0, 1), 1, cA, offA, 0u);
    if (wr == 1) PG8_BAR;
    PG8_WAIT_V(2); PG8_BAR;
    PG8_STAGE(PG8_SB(1, 0), rsB, cB + kstep, voffB); PG8_STAGEA(PG8_SA(1, 0), 0, cA, offA, kstep); PG8_STAGE(PG8_SB(1, 1), rsB, cB + hstepB + kstep, voffB);
    PG8_WAIT_V(6); PG8_BAR;
    for (;;) {
        const bool has_next = S.next(ui + 1, nxt);
        const unsigned nA = (has_next && !GA) ? S.a_off(nxt) : cA, nB = has_next ? S.b_off(nxt) : cB;
        if constexpr (GA) { if (has_next && wid < 4) {
            const __amdgpu_buffer_rsrc_t rsR = __builtin_amdgcn_make_buffer_rsrc((void*)S.rowtab_g(), 0, 0x7fffffff, 0x00020000);
            __builtin_amdgcn_raw_ptr_buffer_load_lds(rsR, (LAS unsigned*)(rowtab + ((ui + 1) & 1) * 1024 + wid * 256), 4, (unsigned)lane * 4u, (unsigned)(nxt.pm * 1024 + wid * 256), 0, 0); } }
        int t0 = 0;
        if constexpr (F8) {
            const unsigned k1 = kstep, k2 = 2u * kstep, k3 = 3u * kstep, b2 = cB + k2, b3 = b2 + kstep;
            PG8_LDB(B0, 0, 0); PG8_LDB(B1, 0, 1); PG8_SCHED; PG8_LDA(At, 0, 0); PG8_STAGEA(PG8_SA(1, 1), 1, cA, offA, k1);
            PG8_WAIT_V(8); PG8_WAIT_L(0); PG8_BAR; PG8_MMAZ(0, 0, At, B0); PG8_MMAZ(0, 1, At, B1); PG8_BAR; PG8_SCHED;
            PG8_LDA(At, 0, 1); PG8_STAGE(PG8_SB(0, 0), rsB, b2, voffB); PG8_STAGE(PG8_SB(0, 1), rsB, b2 + hstepB, voffB); PG8_STAGEA(PG8_SA(0, 0), 0, cA, offA, k2);
            PG8_WAIT_V(8); PG8_WAIT_L(0); PG8_BAR; PG8_MMAZ(1, 0, At, B0); PG8_MMAZ(1, 1, At, B1); PG8_BAR; PG8_SCHED;
            PG8_LDB(B0, 1, 0); PG8_LDB(B1, 1, 1); PG8_SCHED; PG8_LDA(At, 1, 0); PG8_STAGEA(PG8_SA(0, 1), 1, cA, offA, k2);
            PG8_WAIT_V(8); PG8_WAIT_L(0); PG8_BAR; PG8_MMA(0, 0, At, B0); PG8_MMA(0, 1, At, B1); PG8_BAR; PG8_SCHED;
            PG8_LDA(At, 1, 1); PG8_STAGE(PG8_SB(1, 0), rsB, b3, voffB); PG8_STAGE(PG8_SB(1, 1), rsB, b3 + hstepB, voffB); PG8_STAGEA(PG8_SA(1, 0), 0, cA, offA, k3);
            PG8_WAIT_V(8); PG8_WAIT_L(0); PG8_BAR; PG8_MMA(1, 0, At, B0); PG8_MMA(1, 1, At, B1); PG8_BAR; PG8_SCHED;
            t0 = 2;
        }
#pragma unroll 1
        for (int t = t0; t < nt; t += 2) {
            const bool last = (t == nt - 2);
            const unsigned k1 = (unsigned)(t + 1) * kstep, k2 = last ? 0u : (unsigned)(t + 2) * kstep, k3 = k2 + kstep;
            const unsigned uA2 = last ? nA : cA, b2 = (last ? nB : cB) + k2, b3 = b2 + kstep;
            if (last) S.prefetch(pre, cur, w0 & 3, lane & 15, lane >> 4);
            unsigned o2[4] = {0u, 0u, 0u, 0u};
            if constexpr (GA) {
                if (last && has_next) { const LAS int* tb = (const LAS int*)(rowtab + ((ui + 1) & 1) * 1024) + R0;
#pragma unroll
                    for (int j = 0; j < 4; ++j) offN[j] = (unsigned)tb[64 * j] * (unsigned)ROWB + (unsigned)(2 * C0); }
#pragma unroll
                for (int j = 0; j < 4; ++j) o2[j] = last ? offN[j] : offA[j];
            }
            PG8_LDB(B0, 0, 0); PG8_LDB(B1, 0, 1); PG8_SCHED; PG8_LDA(At, 0, 0); PG8_STAGEA(PG8_SA(1, 1), 1, cA, offA, k1);
            PG8_WAIT_V(8); PG8_WAIT_L(0); PG8_BAR; PG8_MMA(0, 0, At, B0); PG8_MMA(0, 1, At, B1); PG8_BAR; PG8_SCHED;
            PG8_LDA(At, 0, 1); PG8_STAGE(PG8_SB(0, 0), rsB, b2, voffB); PG8_STAGE(PG8_SB(0, 1), rsB, b2 + hstepB, voffB); PG8_STAGEA(PG8_SA(0, 0), 0, uA2, o2, k2);
            PG8_WAIT_V(8); PG8_WAIT_L(0); PG8_BAR; PG8_MMA(1, 0, At, B0); PG8_MMA(1, 1, At, B1); PG8_BAR; PG8_SCHED;
            PG8_LDB(B0, 1, 0); PG8_LDB(B1, 1, 1); PG8_SCHED; PG8_LDA(At, 1, 0); PG8_STAGEA(PG8_SA(0, 1), 1, uA2, o2, k2);
            PG8_WAIT_V(8); PG8_WAIT_L(0); PG8_BAR; PG8_MMA(0, 0, At, B0); PG8_MMA(0, 1, At, B1); PG8_BAR; PG8_SCHED;
            PG8_LDA(At, 1, 1); PG8_STAGE(PG8_SB(1, 0), rsB, b3, voffB); PG8_STAGE(PG8_SB(1, 1), rsB, b3 + hstepB, voffB); PG8_STAGEA(PG8_SA(1, 0), 0, uA2, o2, k3);
            PG8_WAIT_V(8); PG8_WAIT_L(0); PG8_BAR; PG8_MMA(1, 0, At, B0); PG8_MMA(1, 1, At, B1); PG8_BAR; PG8_SCHED;
        }
        if (wr == 0) PG8_BAR;
        if constexpr (F8) { asm volatile("s_nop 15\n\ts_nop 15" ::: "memory"); }
        { int te = TIDX(w0); asm volatile("" : "+v"(te)); const int lane2 = te & 63; S.epilogue(acc, cur, w0 >> 2, w0 & 3, lane2 & 15, lane2 >> 4, pre); }
        if (!has_next) break;
        if constexpr (!F8)
#pragma unroll
        for (int a = 0; a < 2; ++a)
#pragma unroll
            for (int b = 0; b < 2; ++b)
#pragma unroll
                for (int m = 0; m < 4; ++m)
#pragma unroll
                    for (int n = 0; n < 2; ++n) acc[a][b][m][n] = (f32x4){0.f, 0.f, 0.f, 0.f};
        cur = nxt; cA = nA; cB = nB; ++ui;
        if constexpr (GA) {
#pragma unroll
            for (int j = 0; j < 4; ++j) offA[j] = offN[j]; }
        if (wr == 1) PG8_BAR;
    }
    PG8_WAIT_V(0);
    PG8_BAR;
#undef PG8_SA
#undef PG8_SB
#undef PG8_STAGE
#undef PG8_STAGEA
#undef PG8_LDA
#undef PG8_LDB
#undef PG8_MMA
#undef PG8_MMAZ
#undef PG8_WAIT_V
#undef PG8_WAIT_L
#undef PG8_BAR
#undef PG8_SCHED
}
}

__device__ __forceinline__ int vunit(int i, int bx, int G) { const int c = (G % 8 == 0) ? (bx % 8) * (G / 8) + bx / 8 : bx; return i * G + c; }

constexpr float W8_SCALE = 64.0f, W8_INV = 1.0f / 64.0f;
struct ProbIn {
    static constexpr int K = 1024; static constexpr bool PERM = true, FP8 = true, GATHER = false;
    const GAS unsigned char* A; const GAS unsigned char* Bt; GAS bf16* O; int last; int bx, G; const GAS float* rope;
    __device__ __forceinline__ bool next(int i, pg8::Unit& u) const {
        const int v = vunit(i, bx, G); const int total = last ? 1824 : 2016; if (v >= total) return false;
        if (!last || v < 1792) { const int g = v / 56, w = v % 56; u.pm = g * 8 + (w & 7); u.pn = w >> 3; } else { u.pm = 256 + (v - 1792); u.pn = 1; }
        u.e = 0; return true; }
    __device__ __forceinline__ const GAS int* rowtab_g() const { return nullptr; }
    __device__ __forceinline__ const GAS void* a_base() const { return A; }
    __device__ __forceinline__ const GAS void* b_base() const { return Bt; }
    __device__ __forceinline__ unsigned a_off(const pg8::Unit& u) const { return (unsigned)u.pm * (256u * K); }
    __device__ __forceinline__ unsigned b_off(const pg8::Unit& u) const { return (unsigned)u.pn * (256u * K); }
    __device__ __forceinline__ unsigned b_hstep() const { return 128u * K; }
    struct Pre { int dummy; };
    __device__ __forceinline__ void prefetch(Pre&, const pg8::Unit&, int, int, int) const {}
    __device__ __forceinline__ void epilogue(const f32x4 (&acc)[2][2][4][2], const pg8::Unit& u, int wr, int wc, int fr, int fq, const Pre&) const {
        const int row0 = u.pm * 256 + wr * 64 + fr, col0 = u.pn * 256 + wc * 32 + 8 * fq;
        const bool ropet = (u.pm < 256) && (u.pn < 2);
#pragma unroll
        for (int ai = 0; ai < 2; ++ai)
#pragma unroll
            for (int m = 0; m < 4; ++m) { GAS bf16* rowp = O + (size_t)(row0 + ai * 128 + m * 16) * INW + col0;
#pragma unroll
                for (int bj = 0; bj < 2; ++bj) { f32x4 v0 = acc[ai][bj][m][0] * W8_INV, v1 = acc[ai][bj][m][1] * W8_INV;
                    if (ropet && (u.pn == 0 || bj == 0)) {
                        const int t = (row0 + ai * 128 + m * 16) & (SEQ - 1); const int pos = (wc & 1) ? (t & 63) : (t >> 6);
                        const GAS float* cp = rope + pos * 16 + 8 * (fq & 1);
                        const f32x4 c0 = *(const GAS f32x4*)cp, c1 = *(const GAS f32x4*)(cp + 4), s0 = *(const GAS f32x4*)(cp + 1024), s1 = *(const GAS f32x4*)(cp + 1028);
                        f32x4 p0, p1;
#pragma unroll
                        for (int j = 0; j < 4; ++j) { p0[j] = xor32_other(v0[j], fq >= 2); p1[j] = xor32_other(v1[j], fq >= 2); }
                        const float sg = (fq < 2) ? -1.0f : 1.0f;
                        v0 = v0 * c0 + (p0 * s0) * sg; v1 = v1 * c1 + (p1 * s1) * sg; }
                    v4u w; w.x = cvt_pk_bf16(v0[0], v0[1]); w.y = cvt_pk_bf16(v0[2], v0[3]); w.z = cvt_pk_bf16(v1[0], v1[1]); w.w = cvt_pk_bf16(v1[2], v1[3]);
                    *(GAS v4u*)(rowp + bj * 128) = w; } }
    }
};
struct ProbOut {
    static constexpr int K = 1024; static constexpr bool PERM = true, FP8 = false, GATHER = false;
    const GAS bf16* A; const GAS bf16* Bt; const GAS float* xin; const GAS float* cin; GAS bf16* xb; GAS float* cout; const GAS float* mod; int nrt; int srcbf; int bx, G;
    __device__ __forceinline__ bool next(int i, pg8::Unit& u) const {
        const int v = vunit(i, bx, G); if (v >= nrt * 4) return false;
        const int g = v >> 5, w = v & 31; u.pm = g * 8 + (w & 7); u.pn = w >> 3; u.e = 0; return true; }
    __device__ __forceinline__ const GAS int* rowtab_g() const { return nullptr; }
    __device__ __forceinline__ const GAS void* a_base() const { return A; }
    __device__ __forceinline__ const GAS void* b_base() const { return Bt; }
    __device__ __forceinline__ unsigned a_off(const pg8::Unit& u) const { return (unsigned)u.pm * (256u * K * 2); }
    __device__ __forceinline__ unsigned b_off(const pg8::Unit& u) const { return (unsigned)u.pn * (256u * K * 2); }
    __device__ __forceinline__ unsigned b_hstep() const { return 128u * K * 2; }
    struct Pre { f32x4 gv[2][2]; };
    __device__ __forceinline__ void prefetch(Pre& p, const pg8::Unit& u, int wc, int fr, int fq) const {
        const int rowt = u.pm * 256; const int bi = (rowt < TX) ? (rowt >> 11) : 32; const GAS float* g1 = mod + (size_t)(bi * 6 + 2) * D + u.pn * 256 + wc * 32 + 8 * fq;
#pragma unroll
        for (int bj = 0; bj < 2; ++bj)
#pragma unroll
            for (int n = 0; n < 2; ++n) p.gv[bj][n] = *(const GAS f32x4*)(g1 + bj * 128 + 4 * n); }
    __device__ __forceinline__ void epilogue(const f32x4 (&acc)[2][2][4][2], const pg8::Unit& u, int wr, int wc, int fr, int fq, const Pre& pre) const {
        const int rowt = u.pm * 256; const bool isx = rowt < TX;
        const int r0 = rowt + wr * 64 + fr, col0 = u.pn * 256 + wc * 32 + 8 * fq;
        if (isx) {
#pragma unroll
            for (int ai = 0; ai < 2; ++ai)
#pragma unroll
                for (int m = 0; m < 4; ++m) { const size_t ro = (size_t)(r0 + ai * 128 + m * 16) * D + col0;
#pragma unroll
                    for (int bj = 0; bj < 2; ++bj) { f32x4 x0, x1;
                        if (srcbf) { const v4u w = *(const GAS v4u*)(xb + ro + bj * 128); x0 = (f32x4){bflo(w.x), bfhi(w.x), bflo(w.y), bfhi(w.y)}; x1 = (f32x4){bflo(w.z), bfhi(w.z), bflo(w.w), bfhi(w.w)}; }
                        else { x0 = *(const GAS f32x4*)(xin + ro + bj * 128); x1 = *(const GAS f32x4*)(xin + ro + bj * 128 + 4); }
                        x0 += pre.gv[bj][0] * acc[ai][bj][m][0]; x1 += pre.gv[bj][1] * acc[ai][bj][m][1];
                        v4u o; o.x = cvt_pk_bf16(x0[0], x0[1]); o.y = cvt_pk_bf16(x0[2], x0[3]); o.z = cvt_pk_bf16(x1[0], x1[1]); o.w = cvt_pk_bf16(x1[2], x1[3]);
                        *(GAS v4u*)(xb + ro + bj * 128) = o; } }
        } else {
#pragma unroll
            for (int ai = 0; ai < 2; ++ai)
#pragma unroll
                for (int m = 0; m < 4; ++m) { const size_t ro = (size_t)(r0 - TX + ai * 128 + m * 16) * D + col0;
#pragma unroll
                    for (int bj = 0; bj < 2; ++bj)
#pragma unroll
                        for (int n = 0; n < 2; ++n) { const f32x4 xi = *(const GAS f32x4*)(cin + ro + bj * 128 + 4 * n);
                            *(GAS f32x4*)(cout + ro + bj * 128 + 4 * n) = xi + pre.gv[bj][n] * acc[ai][bj][m][n]; } }
        }
    }
};
__device__ __forceinline__ unsigned pk4_fp8(float a, float b, float c, float d) {
    a = fminf(fmaxf(a, -448.f), 448.f); b = fminf(fmaxf(b, -448.f), 448.f); c = fminf(fmaxf(c, -448.f), 448.f); d = fminf(fmaxf(d, -448.f), 448.f);
    int w = __builtin_amdgcn_cvt_pk_fp8_f32(a, b, 0, false); w = __builtin_amdgcn_cvt_pk_fp8_f32(c, d, w, true); return (unsigned)w;
}
__device__ __forceinline__ unsigned pk4_fp8_nc(float a, float b, float c, float d) { int w = __builtin_amdgcn_cvt_pk_fp8_f32(a, b, 0, false); w = __builtin_amdgcn_cvt_pk_fp8_f32(c, d, w, true); return (unsigned)w; }
struct Prob1 {
    static constexpr int K = 1024; static constexpr bool PERM = true, FP8 = true, GATHER = true;
    const GAS int* rowtok; const GAS unsigned char* A; const GAS unsigned char* W1; const GAS float* b1; GAS unsigned char* O; const LAS unsigned char* tile_e; int NT; int bx, G;
    __device__ __forceinline__ bool next(int i, pg8::Unit& u) const {
        const int v = vunit(i, bx, G); const int rt = (v >> 6) * 8 + (v & 7); if (rt >= NT) return false;
        u.pm = rt; u.pn = (v & 63) >> 3; u.e = __builtin_amdgcn_readfirstlane((int)tile_e[rt]); return true; }
    __device__ __forceinline__ const GAS void* a_base() const { return A; }
    __device__ __forceinline__ const GAS int* rowtab_g() const { return rowtok; }
    __device__ __forceinline__ const GAS void* b_base() const { return W1; }
    __device__ __forceinline__ unsigned a_off(const pg8::Unit& u) const { return (unsigned)u.pm * (256u * K); }
    __device__ __forceinline__ unsigned b_off(const pg8::Unit& u) const { return ((unsigned)u.e * 2048u + (unsigned)u.pn * 128u) * K; }
    __device__ __forceinline__ unsigned b_hstep() const { return 1024u * K; }
    struct Pre { f32x4 bg[2], bl[2]; };
    __device__ __forceinline__ void prefetch(Pre& p, const pg8::Unit& u, int wc, int fr, int fq) const {
        const GAS float* bb = b1 + (size_t)u.e * 2048 + u.pn * 128 + wc * 32 + 8 * fq;
#pragma unroll
        for (int n = 0; n < 2; ++n) { p.bg[n] = *(const GAS f32x4*)(bb + 4 * n); p.bl[n] = *(const GAS f32x4*)(bb + 1024 + 4 * n); } }
    __device__ __forceinline__ void epilogue(const f32x4 (&acc)[2][2][4][2], const pg8::Unit& u, int wr, int wc, int fr, int fq, const Pre& pre) const {
        const int row0 = u.pm * 256 + wr * 64 + fr, j0 = u.pn * 128 + wc * 32 + 8 * fq;
        const f32x4 (&bg)[2] = pre.bg; const f32x4 (&bl)[2] = pre.bl;
#pragma unroll
        for (int ai = 0; ai < 2; ++ai)
#pragma unroll
            for (int m = 0; m < 4; ++m) { GAS unsigned char* rowp = O + (size_t)(row0 + ai * 128 + m * 16) * 1024 + j0;
                f32x4 rr[2];
#pragma unroll
                for (int n = 0; n < 2; ++n) {
                    f32x4 gl = acc[ai][0][m][n] * W8_INV + bg[n], ln = acc[ai][1][m][n] * W8_INV + bl[n];
                    gl = __builtin_elementwise_min(gl, (f32x4){7.f, 7.f, 7.f, 7.f});
                    ln = __builtin_elementwise_min(__builtin_elementwise_max(ln, (f32x4){-7.f, -7.f, -7.f, -7.f}), (f32x4){7.f, 7.f, 7.f, 7.f});
                    const f32x4 tt = gl * (-1.702f * 1.4426950408889634f); f32x4 den;
                    den.x = __builtin_amdgcn_exp2f(tt.x); den.y = __builtin_amdgcn_exp2f(tt.y); den.z = __builtin_amdgcn_exp2f(tt.z); den.w = __builtin_amdgcn_exp2f(tt.w);
                    den = den + 1.0f; f32x4 sg;
                    sg.x = __builtin_amdgcn_rcpf(den.x); sg.y = __builtin_amdgcn_rcpf(den.y); sg.z = __builtin_amdgcn_rcpf(den.z); sg.w = __builtin_amdgcn_rcpf(den.w);
                    rr[n] = (gl * sg) * (ln + 1.0f); }
                const float r[8] = {rr[0].x, rr[0].y, rr[0].z, rr[0].w, rr[1].x, rr[1].y, rr[1].z, rr[1].w};
                v2u w; w.x = pk4_fp8_nc(r[0], r[1], r[2], r[3]); w.y = pk4_fp8_nc(r[4], r[5], r[6], r[7]);
                *(GAS v2u*)rowp = w; }
    }
};
struct Prob2 {
    static constexpr int K = 1024; static constexpr bool PERM = true, FP8 = true, GATHER = false;
    const GAS unsigned char* A; const GAS unsigned char* W2; const GAS float* b2; GAS unsigned char* O; const LAS unsigned char* tile_e; int NT; int bx, G;
    __device__ __forceinline__ bool next(int i, pg8::Unit& u) const {
        const int v = vunit(i, bx, G); const int rt = (v >> 5) * 8 + (v & 7); if (rt >= NT) return false;
        u.pm = rt; u.pn = (v & 31) >> 3; u.e = __builtin_amdgcn_readfirstlane((int)tile_e[rt]); return true; }
    __device__ __forceinline__ const GAS int* rowtab_g() const { return nullptr; }
    __device__ __forceinline__ const GAS void* a_base() const { return A; }
    __device__ __forceinline__ const GAS void* b_base() const { return W2; }
    __device__ __forceinline__ unsigned a_off(const pg8::Unit& u) const { return (unsigned)u.pm * (256u * K); }
    __device__ __forceinline__ unsigned b_off(const pg8::Unit& u) const { return ((unsigned)u.e * 1024u + (unsigned)u.pn * 256u) * K; }
    __device__ __forceinline__ unsigned b_hstep() const { return 128u * K; }
    struct Pre { f32x4 bv[2][2]; };
    __device__ __forceinline__ void prefetch(Pre& p, const pg8::Unit& u, int wc, int fr, int fq) const {
        const GAS float* bb = b2 + (size_t)u.e * 1024 + u.pn * 256 + wc * 32 + 8 * fq;
#pragma unroll
        for (int bj = 0; bj < 2; ++bj)
#pragma unroll
            for (int n = 0; n < 2; ++n) p.bv[bj][n] = *(const GAS f32x4*)(bb + bj * 128 + 4 * n); }
    __device__ __forceinline__ void epilogue(const f32x4 (&acc)[2][2][4][2], const pg8::Unit& u, int wr, int wc, int fr, int fq, const Pre& pre) const {
        const int row0 = u.pm * 256 + wr * 64 + fr, col0 = u.pn * 256 + wc * 32 + 8 * fq;
        const f32x4 (&bv)[2][2] = pre.bv;
#pragma unroll
        for (int ai = 0; ai < 2; ++ai)
#pragma unroll
            for (int m = 0; m < 4; ++m) { GAS unsigned char* rowp = O + (size_t)(row0 + ai * 128 + m * 16) * 1024 + col0;
#pragma unroll
                for (int bj = 0; bj < 2; ++bj) { const f32x4 v0 = acc[ai][bj][m][0] * W8_INV + bv[bj][0], v1 = acc[ai][bj][m][1] * W8_INV + bv[bj][1];
                    v2u w; w.x = pk4_fp8(v0[0], v0[1], v0[2], v0[3]); w.y = pk4_fp8(v1[0], v1[1], v1[2], v1[3]);
                    *(GAS v2u*)(rowp + bj * 128) = w; } }
    }
};

__device__ __forceinline__ int n2_tile(int wave, int i, int ntile) {
    if (ntile != 18) { const int t = wave + 8 * i; return t < ntile ? t : -1; }
    if (wave < 2) return i == 0 ? 16 + wave : (i == 1 ? wave : -1);
    if (i == 0) return wave;
    if (i == 1) return wave + 6;
    if (i == 2 && wave < 4) return wave + 12;
    return -1;
}
struct Args { const float* in[30]; float* out; unsigned char* ws; int ph_lo, ph_hi; };
enum { I_X = 0, I_C, I_CTX, I_CCTX, I_ADAW, I_ADAB, I_N1G, I_N2G, I_WIN, I_SINK, I_DWW, I_DWB, I_CLNG, I_CLNB, I_CPW, I_GLNG, I_GLNB, I_GWS, I_GBS, I_POOLW, I_PSCALE, I_GNG, I_WOUT, I_RW, I_RB, I_W1, I_B1, I_W2, I_B2, I_FNG };

__device__ __forceinline__ void p0_transpose_item(const GAS float* W, int K, int N, GAS bf16* WT, LAS float* scr, int item, int lane) {
    const int nblk = N / 32, kb = item / nblk, nb = item % nblk, k0 = 64 * kb, n0 = 32 * nb;
#pragma unroll
    for (int i = 0; i < 32; ++i) { const int kk = 2 * i + (lane >> 5); scr[kk * 33 + (lane & 31)] = W[(size_t)(k0 + kk) * N + n0 + (lane & 31)]; }
    LDS_WAIT(); asm volatile("" ::: "memory");
    const int c = lane & 7;
#pragma unroll
    for (int j = 0; j < 4; ++j) { const int n = (lane >> 3) + 8 * j; const LAS float* s = scr + (8 * c) * 33 + n;
        v4u o; o.x = pk2(s[0 * 33], s[1 * 33]); o.y = pk2(s[2 * 33], s[3 * 33]); o.z = pk2(s[4 * 33], s[5 * 33]); o.w = pk2(s[6 * 33], s[7 * 33]);
        *(GAS v4u*)(WT + (size_t)(n0 + n) * K + k0 + 8 * c) = o; }
    LDS_WAIT(); asm volatile("" ::: "memory");
}

struct P0Item { const GAS float* src; GAS unsigned char* dst; int N; };
__device__ __forceinline__ P0Item p0_f8_decode(int r, const GAS float* w1, const GAS float* w2, const GAS float* win, GAS unsigned char* W1_T, GAS unsigned char* W2_T, GAS unsigned char* WIN_T, int lane) {
    const int kg = lane >> 3, n4 = (lane & 7) * 4; P0Item it;
    if (r < 32768) { const int mi = r >> 9, li = r & 511, kb = li >> 6, nb = li & 63; it.N = 2048;
        it.src = w1 + (size_t)mi * 1024 * 2048 + (size_t)(128 * kb + 16 * kg) * 2048 + 32 * nb + n4; it.dst = W1_T + (size_t)mi * 2048 * 1024 + (size_t)(32 * nb + n4) * 1024 + 128 * kb + 16 * kg; }
    else if (r < 49152) { const int r2 = r - 32768, mi = r2 >> 8, li = r2 & 255, kb = li >> 5, nb = li & 31; it.N = 1024;
        it.src = w2 + (size_t)mi * 1024 * 1024 + (size_t)(128 * kb + 16 * kg) * 1024 + 32 * nb + n4; it.dst = W2_T + (size_t)mi * 1024 * 1024 + (size_t)(32 * nb + n4) * 1024 + 128 * kb + 16 * kg; }
    else { const int r2 = r - 49152, mi = r2 / 448, li = r2 % 448, kb = li / 56, nb = li % 56; it.N = 1792;
        it.src = win + (size_t)mi * 1024 * 1792 + (size_t)(128 * kb + 16 * kg) * 1792 + 32 * nb + n4; it.dst = WIN_T + (size_t)mi * 1792 * 1024 + (size_t)(32 * nb + n4) * 1024 + 128 * kb + 16 * kg; }
    return it;
}
__device__ __forceinline__ void p0_f8_load(const P0Item& it, f32x4 (&ld)[16]) {
#pragma unroll
    for (int i = 0; i < 16; ++i) ld[i] = __builtin_nontemporal_load((const GAS f32x4*)(it.src + (size_t)i * it.N));
}
__device__ __forceinline__ void p0_f8_store(GAS unsigned char* dst, const f32x4 (&ld)[16]) {
    unsigned T[4][4];
#pragma unroll
    for (int q = 0; q < 4; ++q) {
        unsigned Dw[4];
#pragma unroll
        for (int r = 0; r < 4; ++r) { const f32x4 v = ld[4 * q + r] * W8_SCALE; Dw[r] = pk4_fp8_nc(v.x, v.y, v.z, v.w); }
        const unsigned X0 = __builtin_amdgcn_perm(Dw[1], Dw[0], 0x05010400u), X1 = __builtin_amdgcn_perm(Dw[1], Dw[0], 0x07030602u);
        const unsigned Y0 = __builtin_amdgcn_perm(Dw[3], Dw[2], 0x05010400u), Y1 = __builtin_amdgcn_perm(Dw[3], Dw[2], 0x07030602u);
        T[0][q] = __builtin_amdgcn_perm(Y0, X0, 0x05040100u); T[1][q] = __builtin_amdgcn_perm(Y0, X0, 0x07060302u);
        T[2][q] = __builtin_amdgcn_perm(Y1, X1, 0x05040100u); T[3][q] = __builtin_amdgcn_perm(Y1, X1, 0x07060302u);
    }
#pragma unroll
    for (int j = 0; j < 4; ++j) { v4u o; o.x = T[j][0]; o.y = T[j][1]; o.z = T[j][2]; o.w = T[j][3]; *(GAS v4u*)(dst + (size_t)j * 1024) = o; }
}

template <bool COMB>
__device__ __forceinline__ void load_row(const GAS float* src, int r, const GAS int* slot, const GAS float* gate, const GAS bf16* Y, const GAS float* g2, int lane, f32x4 (&v)[4]) {
#pragma unroll
    for (int j = 0; j < 4; ++j) v[j] = COMB ? ((const GAS f32x4*)src)[lane + 64 * j] : __builtin_nontemporal_load((const GAS f32x4*)src + lane + 64 * j);
    if (COMB) {
        f32x4 dl[4];
#pragma unroll
        for (int j = 0; j < 4; ++j) dl[j] = (f32x4){0.f, 0.f, 0.f, 0.f};
#pragma unroll
        for (int k = 0; k < 4; ++k) { const int s = slot[r * 4 + k]; const float gt = gate[r * 4 + k]; const GAS v2u* yp = (const GAS v2u*)(Y + (size_t)s * 1024);
#pragma unroll
            for (int j = 0; j < 4; ++j) { const v2u w = yp[lane + 64 * j]; dl[j] += gt * (f32x4){bflo(w.x), bfhi(w.x), bflo(w.y), bfhi(w.y)}; } }
#pragma unroll
        for (int j = 0; j < 4; ++j) v[j] += ((const GAS f32x4*)g2)[lane + 64 * j] * dl[j];
    }
}
typedef float f32x2_ __attribute__((ext_vector_type(2)));
__device__ __forceinline__ f32x4 unpk4_fp8(unsigned w) { const f32x2_ lo = __builtin_amdgcn_cvt_pk_f32_fp8((int)w, false), hi = __builtin_amdgcn_cvt_pk_f32_fp8((int)w, true); return (f32x4){lo.x, lo.y, hi.x, hi.y}; }
__device__ __forceinline__ void ld_row_any(const GAS void* src, bool bf, int lane, f32x4 (&v)[4]) {
    if (bf) {
#pragma unroll
        for (int j = 0; j < 4; ++j) { const v2u w = ((const GAS v2u*)src)[lane + 64 * j]; v[j] = (f32x4){bflo(w.x), bfhi(w.x), bflo(w.y), bfhi(w.y)}; }
    } else {
#pragma unroll
        for (int j = 0; j < 4; ++j) v[j] = ((const GAS f32x4*)src)[lane + 64 * j];
    }
}
__device__ __forceinline__ void st_row_bf16(GAS bf16* dst, int lane, const f32x4 (&v)[4]) {
#pragma unroll
    for (int j = 0; j < 4; ++j) { v2u w; w.x = pk2(v[j].x, v[j].y); w.y = pk2(v[j].z, v[j].w); ((GAS v2u*)dst)[lane + 64 * j] = w; }
}
__device__ __forceinline__ void ld_row_any_nt(const GAS void* src, bool bf, int lane, f32x4 (&v)[4]) {
    if (bf) {
#pragma unroll
        for (int j = 0; j < 4; ++j) { const v2u w = __builtin_nontemporal_load((const GAS v2u*)src + lane + 64 * j); v[j] = (f32x4){bflo(w.x), bfhi(w.x), bflo(w.y), bfhi(w.y)}; }
    } else {
#pragma unroll
        for (int j = 0; j < 4; ++j) v[j] = __builtin_nontemporal_load((const GAS f32x4*)src + lane + 64 * j);
    }
}
template <bool COMB>
__device__ __forceinline__ void load_row2(const GAS void* srca, bool bfa, const GAS void* srcb, bool bfb, int ra, int rb, const GAS int* slot, const GAS float* gate, const GAS unsigned char* Y, const GAS float* g2a, const GAS float* g2b, int lane, f32x4 (&va)[4], f32x4 (&vb)[4]) {
    ld_row_any_nt(srca, bfa, lane, va); ld_row_any_nt(srcb, bfb, lane, vb);
    if (COMB) {
        int sa[4], sb[4]; float ga[4], gb[4];
#pragma unroll
        for (int k = 0; k < 4; ++k) { sa[k] = slot[ra * 4 + k]; sb[k] = slot[rb * 4 + k]; ga[k] = gate[ra * 4 + k]; gb[k] = gate[rb * 4 + k]; }
        unsigned ya[4][4], yb[4][4];
#pragma unroll
        for (int k = 0; k < 4; ++k)
#pragma unroll
            for (int j = 0; j < 4; ++j) { ya[k][j] = ((const GAS unsigned*)(Y + (size_t)sa[k] * 1024))[lane + 64 * j]; yb[k][j] = ((const GAS unsigned*)(Y + (size_t)sb[k] * 1024))[lane + 64 * j]; }
#pragma unroll
        for (int j = 0; j < 4; ++j) { f32x4 da = (f32x4){0.f, 0.f, 0.f, 0.f}, db = (f32x4){0.f, 0.f, 0.f, 0.f};
#pragma unroll
            for (int k = 0; k < 4; ++k) { da += ga[k] * unpk4_fp8(ya[k][j]); db += gb[k] * unpk4_fp8(yb[k][j]); }
            va[j] += ((const GAS f32x4*)g2a)[lane + 64 * j] * da; vb[j] += ((const GAS f32x4*)g2b)[lane + 64 * j] * db; }
    }
}
__device__ __forceinline__ float row_rstd(const f32x4 (&v)[4]) {
    float ss = 0.f;
#pragma unroll
    for (int j = 0; j < 4; ++j) ss += (v[j].x * v[j].x + v[j].y * v[j].y) + (v[j].z * v[j].z + v[j].w * v[j].w);
    ss = wave_sum(ss);
    return __builtin_amdgcn_rsqf(ss * (1.0f / D) + EPS);
}
__device__ __forceinline__ void mod_store_fp8(const f32x4 (&v)[4], float rstd, const GAS float* g, const GAS float* sc, const GAS float* sh, GAS unsigned char* orow, int lane) {
#pragma unroll
    for (int j = 0; j < 4; ++j) { const f32x4 gg = ((const GAS f32x4*)g)[lane + 64 * j], s1 = ((const GAS f32x4*)sc)[lane + 64 * j], s0 = ((const GAS f32x4*)sh)[lane + 64 * j];
        const f32x4 hh = (v[j] * rstd * gg) * (s1 + 1.0f) + s0;
        ((GAS unsigned*)orow)[lane + 64 * j] = pk4_fp8(hh.x, hh.y, hh.z, hh.w); }
}
__device__ __forceinline__ void mod_store_bf16(const f32x4 (&v)[4], float rstd, const GAS float* g, const GAS float* sc, const GAS float* sh, GAS bf16* orow, int lane, f32x4 (&h)[4]) {
#pragma unroll
    for (int j = 0; j < 4; ++j) { const f32x4 gg = ((const GAS f32x4*)g)[lane + 64 * j], s1 = ((const GAS f32x4*)sc)[lane + 64 * j], s0 = ((const GAS f32x4*)sh)[lane + 64 * j];
        h[j] = (v[j] * rstd * gg) * (s1 + 1.0f) + s0;
        v2u w; w.x = pk2(h[j].x, h[j].y); w.y = pk2(h[j].z, h[j].w); ((GAS v2u*)orow)[lane + 64 * j] = w; }
}

typedef float f32x16 __attribute__((ext_vector_type(16)));
#define MFMA32(a, b, c) __builtin_amdgcn_mfma_f32_32x32x16_bf16((a), (b), (c), 0, 0, 0)
constexpr int AT_KST = 144, AT_VST = 264, AT_KB = 128 * AT_KST, AT_VB = 64 * AT_VST, AT_BUF = AT_KB + AT_VB, AT_SS = 3 * AT_BUF;
#define AT_TILE(NB, MASK) do { \
    f32x16 S[NB]; \
    _Pragma("unroll") for (int mt = 0; mt < NB; ++mt) _Pragma("unroll") for (int r = 0; r < 16; ++r) S[mt][r] = 0.f; \
    { bf16x8 kf[2][NB]; \
      _Pragma("unroll") for (int mt = 0; mt < NB; ++mt) kf[0][mt] = *(const LAS bf16x8*)(lds + kofs[mt] + kl); \
      _Pragma("unroll") for (int s4 = 0; s4 < 4; ++s4) { \
          if (s4 < 3) { _Pragma("unroll") for (int mt = 0; mt < NB; ++mt) kf[(s4 + 1) & 1][mt] = *(const LAS bf16x8*)(lds + kofs[mt] + kl + 32 * (s4 + 1)); } \
          _Pragma("unroll") for (int mt = 0; mt < NB; ++mt) S[mt] = MFMA32(kf[s4 & 1][mt], qf[s4], S[mt]); } \
      __builtin_amdgcn_sched_group_barrier(0x100, 2 * NB, 0); \
      _Pragma("unroll") for (int i = 0; i < 2 * NB; ++i) { __builtin_amdgcn_sched_group_barrier(0x008, 1, 0); __builtin_amdgcn_sched_group_barrier(0x100, 1, 0); } \
      __builtin_amdgcn_sched_group_barrier(0x008, 2 * NB, 0); } \
    MASK \
    float mx; \
    { f32x16 m4 = S[0]; _Pragma("unroll") for (int mt = 1; mt < NB; ++mt) m4 = __builtin_elementwise_max(m4, S[mt]); \
      float a0 = fmaxf(fmaxf(m4[0], m4[1]), m4[2]), a1 = fmaxf(fmaxf(m4[3], m4[4]), m4[5]), a2 = fmaxf(fmaxf(m4[6], m4[7]), m4[8]), a3 = fmaxf(fmaxf(m4[9], m4[10]), m4[11]), a4 = fmaxf(fmaxf(m4[12], m4[13]), m4[14]); \
      mx = fmaxf(fmaxf(fmaxf(a0, a1), fmaxf(a2, a3)), fmaxf(a4, m4[15])); } \
    mx = xor32_max(mx); \
    const float msn = fmaxf(ms, mx * C1), corr = __builtin_amdgcn_exp2f(ms - msn); \
    ms = msn; lsum *= corr; \
    O0 = O0 * corr; O1 = O1 * corr; \
    f32x16 psv; \
    _Pragma("unroll") for (int mt = 0; mt < NB; ++mt) { const f32x16 tsc = S[mt] * C1 - ms; \
        _Pragma("unroll") for (int r = 0; r < 16; ++r) S[mt][r] = __builtin_amdgcn_exp2f(tsc[r]); \
        psv = (mt == 0) ? S[0] : psv + S[mt]; } \
    { float ps = ((psv[0] + psv[1]) + (psv[2] + psv[3])) + ((psv[4] + psv[5]) + (psv[6] + psv[7])) + (((psv[8] + psv[9]) + (psv[10] + psv[11])) + ((psv[12] + psv[13]) + (psv[14] + psv[15]))); \
      lsum += ps; } \
    _Pragma("unroll") for (int mt = 0; mt < NB; ++mt) _Pragma("unroll") for (int sp = 0; sp < 2; ++sp) { \
        v4u pw; pw.x = cvt_pk_bf16(S[mt][8 * sp + 0], S[mt][8 * sp + 1]); pw.y = cvt_pk_bf16(S[mt][8 * sp + 2], S[mt][8 * sp + 3]); \
        pw.z = cvt_pk_bf16(S[mt][8 * sp + 4], S[mt][8 * sp + 5]); pw.w = cvt_pk_bf16(S[mt][8 * sp + 6], S[mt][8 * sp + 7]); \
        const bf16x8 pb = __builtin_bit_cast(bf16x8, pw); \
        const LAS unsigned char* vp = lds + vofs[mt] + vl + 32 * sp; \
        { const v2u a0 = *(const LAS v2u*)vp, a1 = *(const LAS v2u*)(vp + 16); v4u vw; vw.x = a0.x; vw.y = a0.y; vw.z = a1.x; vw.w = a1.y; O0 = MFMA32(__builtin_bit_cast(bf16x8, vw), pb, O0); } \
        { const v2u a0 = *(const LAS v2u*)(vp + 32 * AT_VST), a1 = *(const LAS v2u*)(vp + 32 * AT_VST + 16); v4u vw; vw.x = a0.x; vw.y = a0.y; vw.z = a1.x; vw.w = a1.y; O1 = MFMA32(__builtin_bit_cast(bf16x8, vw), pb, O1); } } \
    } while (0)
__device__ __forceinline__ void attn_mfma(const GAS bf16* PX, GAS bf16* MIX, const GAS float* sink, const GAS float* gng, LAS unsigned char* lds, int nunits, const int w0_) {
    const int w0 = opq(w0_);
    const int tid = TIDX(w0), lane = tid & 63, wave = w0;
    const int g = wave >> 2, qi0 = (wave & 3) * 32, ql = lane & 31, hi = lane >> 5;
    const float LOG2E = 1.4426950408889634f, C1 = 0.125f * LOG2E;
    LAS float* ssT = (LAS float*)(lds + AT_SS);
    const int kl = ql * AT_KST + 16 * hi, vl = ql * AT_VST + 8 * hi;
    const int bx_ = bidx_(), gd_ = gdim_();
    for (int uu_ = bx_; uu_ < nunits; uu_ += gd_) { int u = uu_;
        if (uu_ < 512 && gd_ == 256) { const int k_ = uu_ >> 8, c_ = uu_ & 255, xcd_ = c_ & 7, j_ = c_ >> 3; u = ((k_ * 16 + xcd_ * 2 + (j_ >> 4)) << 4) | (j_ & 15); }
        const bool isx = u < 512;
        const int b = isx ? (u >> 4) : ((u - 512) >> 1);
        const int n = u & 15;
        const int rowbase = isx ? (b * SEQ + n * 128) : (TX + b * CTXL + (u & 1) * 128);
        const int qrow = rowbase + qi0 + ql, qi = qi0 + ql;
        const int nfull = isx ? 3 : 2;
        const bool validA = n > 0, validB = n < 15;
        f32x16 Oa[2], O0, O1;
#pragma unroll 1
        for (int kvh = 0; kvh < 2; ++kvh) {
            const int h = kvh * 2 + g;
            bf16x8 qf[4];
#pragma unroll
            for (int s4 = 0; s4 < 4; ++s4) qf[s4] = *(const GAS bf16x8*)(PX + (size_t)qrow * INW + h * 64 + 16 * s4 + 8 * hi);
            float ms = sink[h] * LOG2E, lsum = (hi == 0) ? 1.0f : 0.0f;
#pragma unroll
            for (int r = 0; r < 16; ++r) { O0[r] = 0.f; O1[r] = 0.f; }
            v4u kreg[2], vreg[2];
#define AT_LOADR(r0) do { const int r0_ = (r0); _Pragma("unroll") for (int i_ = 0; i_ < 2; ++i_) { const int p_ = tid + 512 * i_; \
                const GAS bf16* gp_ = PX + (size_t)(r0_ + (p_ >> 3)) * INW + OFF_K + kvh * 64 + (p_ & 7) * 8; kreg[i_] = *(const GAS v4u*)gp_; vreg[i_] = *(const GAS v4u*)(gp_ + (OFF_V - OFF_K)); } } while (0)
#define AT_WRITE(bufp) do { _Pragma("unroll") for (int i_ = 0; i_ < 2; ++i_) { const int p_ = tid + 512 * i_; const int key_ = p_ >> 3, ch_ = p_ & 7; \
                *(LAS v4u*)((bufp) + key_ * AT_KST + ch_ * 16) = kreg[i_]; \
                LAS unsigned short* vt_ = (LAS unsigned short*)((bufp) + AT_KB + (ch_ * 8) * AT_VST + key_ * 2); \
                vt_[0 * (AT_VST / 2)] = (unsigned short)(vreg[i_].x & 0xffffu); vt_[1 * (AT_VST / 2)] = (unsigned short)(vreg[i_].x >> 16); \
                vt_[2 * (AT_VST / 2)] = (unsigned short)(vreg[i_].y & 0xffffu); vt_[3 * (AT_VST / 2)] = (unsigned short)(vreg[i_].y >> 16); \
                vt_[4 * (AT_VST / 2)] = (unsigned short)(vreg[i_].z & 0xffffu); vt_[5 * (AT_VST / 2)] = (unsigned short)(vreg[i_].z >> 16); \
                vt_[6 * (AT_VST / 2)] = (unsigned short)(vreg[i_].w & 0xffffu); vt_[7 * (AT_VST / 2)] = (unsigned short)(vreg[i_].w >> 16); } } while (0)
            AT_LOADR(TX + b * CTXL);
            if (isx) {
                v4u k2[2], v2[2]; const int r0b = b * SEQ + (validB ? n + 1 : n) * 128;
#pragma unroll
                for (int i_ = 0; i_ < 2; ++i_) { const int p_ = tid + 512 * i_; const GAS bf16* gp_ = PX + (size_t)(r0b + (p_ >> 3)) * INW + OFF_K + kvh * 64 + (p_ & 7) * 8; k2[i_] = *(const GAS v4u*)gp_; v2[i_] = *(const GAS v4u*)(gp_ + (OFF_V - OFF_K)); }
                AT_WRITE(lds);
#pragma unroll
                for (int i_ = 0; i_ < 2; ++i_) { kreg[i_] = k2[i_]; vreg[i_] = v2[i_]; }
                AT_WRITE(lds + 2 * AT_BUF);
            } else AT_WRITE(lds);
            __syncthreads();
#pragma unroll 1
            for (int i = 0; i < nfull; ++i) {
                const bool hasn = (i + 1 < nfull) || isx;
                if (hasn) { const int r0n = (i == 0) ? (TX + b * CTXL + 128) : (i == 1) ? (b * SEQ + n * 128) : (b * SEQ + (validA ? n - 1 : n) * 128); AT_LOADR(r0n); }
                const int bo = (i & 1) * AT_BUF;
                int kofs[4], vofs[4];
#pragma unroll
                for (int mt = 0; mt < 4; ++mt) { kofs[mt] = bo + 32 * mt * AT_KST; vofs[mt] = bo + AT_KB + 64 * mt; }
                AT_TILE(4, );
                if (hasn) AT_WRITE(lds + ((i + 1) & 1) * AT_BUF);
                __syncthreads();
            }
            if (isx) {
                const int wq = w0 & 3;
                int kofs[5], vofs[5];
#pragma unroll
                for (int mt = 0; mt < 4; ++mt) { const int so = (mt < wq) ? 2 * AT_BUF : AT_BUF; kofs[mt] = so + 32 * mt * AT_KST; vofs[mt] = so + AT_KB + 64 * mt; }
                kofs[4] = 2 * AT_BUF + 32 * wq * AT_KST; vofs[4] = 2 * AT_BUF + AT_KB + 64 * wq;
#define AT_EDGE_MASK { int dq = ql - 4 * hi; asm volatile("" : "+v"(dq)); \
                    _Pragma("unroll") for (int mt = 0; mt < 4; ++mt) { \
                        const bool dead = (mt < wq) ? !validB : !validA; \
                        if (dead) { _Pragma("unroll") for (int r = 0; r < 16; ++r) S[mt][r] = -1.0e30f; } \
                        else if (mt == wq) { _Pragma("unroll") for (int r = 0; r < 16; ++r) { const int c = (r & 3) + 8 * (r >> 2); S[mt][r] = (c < dq) ? -1.0e30f : S[mt][r]; } } } \
                    if (!validB) { _Pragma("unroll") for (int r = 0; r < 16; ++r) S[4][r] = -1.0e30f; } \
                    else { _Pragma("unroll") for (int r = 0; r < 16; ++r) { const int c = (r & 3) + 8 * (r >> 2); S[4][r] = (c > dq) ? -1.0e30f : S[4][r]; } } }
                AT_TILE(5, AT_EDGE_MASK);
#undef AT_EDGE_MASK
                __syncthreads();
            }
#undef AT_LOADR
#undef AT_WRITE
            lsum = xor32_sum(lsum);
            const float inv = __builtin_amdgcn_rcpf(lsum); float ssq = 0.f;
#pragma unroll
            for (int r = 0; r < 16; ++r) { O0[r] *= inv; O1[r] *= inv; ssq += O0[r] * O0[r] + O1[r] * O1[r]; }
            ssq = xor32_sum(ssq);
            if (hi == 0) ssT[h * 128 + qi] = ssq;
            if (kvh == 0) { Oa[0] = O0; Oa[1] = O1; }
        }
        __syncthreads();
        const float tot = ssT[qi] + ssT[128 + qi] + ssT[256 + qi] + ssT[384 + qi];
        const float rstd = __builtin_amdgcn_rsqf(tot * (1.0f / 256.0f) + EPS);
        GAS bf16* orow = MIX + (size_t)qrow * D;
        const GAS float* gngo = gng; asm volatile("" : "+s"(gngo));
#pragma unroll
        for (int kv = 0; kv < 2; ++kv)
#pragma unroll
            for (int dt = 0; dt < 2; ++dt)
#pragma unroll
                for (int k4 = 0; k4 < 4; ++k4) { const int hh = kv * 2 + g, d = 32 * dt + 8 * k4 + 4 * hi; const f32x4 gg = *(const GAS f32x4*)(gngo + hh * 64 + d);
                    const f32x16& src = kv == 0 ? Oa[dt] : (dt == 0 ? O0 : O1);
                    v2u w; w.x = pk2(src[4 * k4 + 0] * rstd * gg.x, src[4 * k4 + 1] * rstd * gg.y); w.y = pk2(src[4 * k4 + 2] * rstd * gg.z, src[4 * k4 + 3] * rstd * gg.w);
                    *(GAS v2u*)(orow + hh * 64 + d) = w; }
        __syncthreads();
    }
}
#undef AT_TILE

#define MFMA16(a, b, c) __builtin_amdgcn_mfma_f32_16x16x32_bf16((a), (b), (c), 0, 0, 0)
constexpr int CV_HG = 0, CV_CV = 94 * 512, CV_Z = CV_CV + 64 * 512, CV_ZST = 528, CV_SS = CV_Z + 64 * CV_ZST;
__device__ __forceinline__ void conv_mfma(const GAS bf16* PX, GAS bf16* MIX, const GAS float* dww, const GAS float* dwb, const GAS float* lng, const GAS float* lnb, const GAS bf16* cpwT, const GAS float* gng, LAS unsigned char* lds, int nunits, const int w0_) {
    const int w0 = opq(w0_);
    const int tid = TIDX(w0), wave = w0, lane = tid & 63, fr = lane & 15, fq = lane >> 4;
    LAS unsigned char* hgb = lds + CV_HG; LAS unsigned char* cvb = lds + CV_CV; LAS unsigned char* zb = lds + CV_Z; LAS float* ssw = (LAS float*)(lds + CV_SS);
    const int cp = tid & 127, tg = tid >> 7;
    const int gd_ = gdim_(); int bx_ = bidx_() + 192; if (bx_ >= gd_) bx_ -= gd_;
    v2u ra[12], rg[12];
#define CV_LOAD(uu, i0, i1) do { int rb_, t0_, Ls_; if ((uu) < 1024) { rb_ = ((uu) >> 5) * SEQ; t0_ = ((uu) & 31) * 64; Ls_ = SEQ; } else { const int u2_ = (uu) - 1024; rb_ = TX + (u2_ >> 2) * CTXL; t0_ = (u2_ & 3) * 64; Ls_ = CTXL; } \
        _Pragma("unroll") for (int it = (i0); it < (i1); ++it) { const int idx = tid + 512 * it, tt = idx >> 6, c4 = (idx & 63) * 4, t = t0_ - 15 + tt; const bool ok = (tt < 94) && t >= 0 && t < Ls_; \
            const GAS bf16* rp = PX + (size_t)(rb_ + (ok ? t : t0_)) * INW + OFF_CONV + c4; ra[it] = *(const GAS v2u*)rp; rg[it] = *(const GAS v2u*)(rp + 256); } } while (0)
    if (bx_ < nunits) CV_LOAD(bx_, 0, 6);
    for (int u = bx_; u < nunits; u += gd_) {
        int rowbase, t0, Ls;
        if (u < 1024) { rowbase = (u >> 5) * SEQ; t0 = (u & 31) * 64; Ls = SEQ; } else { const int u2 = u - 1024; rowbase = TX + (u2 >> 2) * CTXL; t0 = (u2 & 3) * 64; Ls = CTXL; }
        CV_LOAD(u, 6, 12);
#pragma unroll
        for (int it = 0; it < 12; ++it) { const int idx = tid + 512 * it, tt = idx >> 6, c4 = (idx & 63) * 4, t = t0 - 15 + tt; const bool ok = (tt < 94) && t >= 0 && t < Ls;
            const v2u av = ok ? ra[it] : (v2u){0u, 0u}, gv = rg[it];
            v2u w; w.x = pk2(bflo(av.x) * sigmoidf_(bflo(gv.x)), bfhi(av.x) * sigmoidf_(bfhi(gv.x))); w.y = pk2(bflo(av.y) * sigmoidf_(bflo(gv.y)), bfhi(av.y) * sigmoidf_(bfhi(gv.y)));
            if (tt < 94) *(LAS v2u*)(hgb + (tt * 256 + c4) * 2) = w; }
        if (u + gd_ < nunits) CV_LOAD(u + gd_, 0, 6);
        f32x2 wreg[31];
        { const GAS float* dwwo = dww; asm volatile("" : "+s"(dwwo));
#pragma unroll
          for (int j = 0; j < 31; ++j) wreg[j] = *(const GAS f32x2*)(dwwo + j * 256 + 2 * cp); }
        __syncthreads();
        {
            const f32x2 bias = *(const GAS f32x2*)(dwb + 2 * cp);
#pragma unroll 1
            for (int hp8 = 0; hp8 < 2; ++hp8) { const int tb = tg * 16 + hp8 * 8; f32x2 a2[8];
#pragma unroll
                for (int tt = 0; tt < 8; ++tt) a2[tt] = bias;
                { f32x2 win[23];
#pragma unroll
                  for (int j = 0; j < 23; ++j) { const unsigned w = *(const LAS unsigned*)(hgb + ((tb + j) * 256 + 2 * cp) * 2); win[j] = (f32x2){bflo(w), bfhi(w)}; }
#pragma unroll
                  for (int tt = 0; tt < 8; ++tt)
#pragma unroll
                      for (int j = 0; j < 16; ++j) a2[tt] = a2[tt] + win[tt + j] * wreg[j]; }
                asm volatile("" ::: "memory"); __builtin_amdgcn_sched_barrier(0);
                { f32x2 win[22];
#pragma unroll
                  for (int j = 0; j < 22; ++j) { const unsigned w = *(const LAS unsigned*)(hgb + ((tb + 16 + j) * 256 + 2 * cp) * 2); win[j] = (f32x2){bflo(w), bfhi(w)}; }
#pragma unroll
                  for (int tt = 0; tt < 8; ++tt)
#pragma unroll
                      for (int j = 16; j < 31; ++j) a2[tt] = a2[tt] + win[tt + j - 16] * wreg[j]; }
#pragma unroll
                for (int tt = 0; tt < 8; ++tt) *(LAS unsigned*)(cvb + ((tb + tt) * 256 + 2 * cp) * 2) = pk2(a2[tt].x, a2[tt].y);
                asm volatile("" ::: "memory"); __builtin_amdgcn_sched_barrier(0); } }
        __syncthreads();
        bf16x8 wf[2][8];
#pragma unroll
        for (int nt = 0; nt < 2; ++nt)
#pragma unroll
            for (int s8 = 0; s8 < 8; ++s8) wf[nt][s8] = *(const GAS bf16x8*)(cpwT + (size_t)(32 * wave + 16 * nt + fr) * 256 + 32 * s8 + 8 * fq);
        { const f32x4 lg = *(const GAS f32x4*)(lng + lane * 4), lb = *(const GAS f32x4*)(lnb + lane * 4);
          for (int tt = wave; tt < 64; tt += 8) { const v2u raw = *(const LAS v2u*)(cvb + (tt * 256 + lane * 4) * 2); float v[4] = {bflo(raw.x), bfhi(raw.x), bflo(raw.y), bfhi(raw.y)};
            const float mean = wave_sum((v[0] + v[1]) + (v[2] + v[3])) * (1.0f / 256.0f); float s2 = 0.f;
#pragma unroll
            for (int j = 0; j < 4; ++j) { v[j] -= mean; s2 += v[j] * v[j]; }
            const float rstd = __builtin_amdgcn_rsqf(wave_sum(s2) * (1.0f / 256.0f) + EPS);
            float y[4] = {v[0] * rstd * lg.x + lb.x, v[1] * rstd * lg.y + lb.y, v[2] * rstd * lg.z + lb.z, v[3] * rstd * lg.w + lb.w};
#pragma unroll
            for (int j = 0; j < 4; ++j) y[j] = y[j] * sigmoidf_(y[j]);
            v2u w; w.x = pk2(y[0], y[1]); w.y = pk2(y[2], y[3]); *(LAS v2u*)(zb + tt * CV_ZST + lane * 8) = w; } }
        __syncthreads();
        f32x4 acc[2][4];
#pragma unroll
        for (int nt = 0; nt < 2; ++nt)
#pragma unroll
            for (int tt = 0; tt < 4; ++tt) acc[nt][tt] = (f32x4){0.f, 0.f, 0.f, 0.f};
#pragma unroll
        for (int s8 = 0; s8 < 8; ++s8) {
            bf16x8 zf[4];
#pragma unroll
            for (int tt = 0; tt < 4; ++tt) zf[tt] = *(const LAS bf16x8*)(zb + (16 * tt + fr) * CV_ZST + (32 * s8 + 8 * fq) * 2);
#pragma unroll
            for (int nt = 0; nt < 2; ++nt)
#pragma unroll
                for (int tt = 0; tt < 4; ++tt) acc[nt][tt] = MFMA16(wf[nt][s8], zf[tt], acc[nt][tt]);
        }
#pragma unroll
        for (int tt = 0; tt < 4; ++tt) { float ss = 0.f;
#pragma unroll
            for (int nt = 0; nt < 2; ++nt)
#pragma unroll
                for (int rg = 0; rg < 4; ++rg) ss += acc[nt][tt][rg] * acc[nt][tt][rg];
            ss = xor16_sum(ss); ss = xor32_sum(ss);
            if (fq == 0) ssw[wave * 64 + 16 * tt + fr] = ss; }
        __syncthreads();
#pragma unroll
        for (int tt = 0; tt < 4; ++tt) { const int tk = 16 * tt + fr; float tot = 0.f;
#pragma unroll
            for (int w8 = 0; w8 < 8; ++w8) tot += ssw[w8 * 64 + tk];
            const float rstd = __builtin_amdgcn_rsqf(tot * (1.0f / 256.0f) + EPS);
#pragma unroll
            for (int nt = 0; nt < 2; ++nt) { const int n0 = 32 * wave + 16 * nt + 4 * fq; const f32x4 gg = *(const GAS f32x4*)(gng + 256 + n0);
                v2u w; w.x = pk2(acc[nt][tt][0] * rstd * gg.x, acc[nt][tt][1] * rstd * gg.y); w.y = pk2(acc[nt][tt][2] * rstd * gg.z, acc[nt][tt][3] * rstd * gg.w);
                *(GAS v2u*)(MIX + (size_t)(rowbase + t0 + tk) * D + 256 + n0) = w; } }
        __syncthreads();
    }
#undef CV_LOAD
}

constexpr int GM_VST = 272, GM_SS = 256 * GM_VST;
__device__ __forceinline__ void gmlp_mfma(const GAS bf16* PX, GAS bf16* MIX, const GAS float* lng, const GAS float* lnb, const GAS bf16* gwsb, const GAS float* gbs, const GAS float* gng, LAS unsigned char* lds, int nunits, const int w0_) {
    const int w0 = opq(w0_);
    const int tid = TIDX(w0), wave = w0, lane = tid & 63, fr = lane & 15, fq = lane >> 4;
    LAS float* ssh = (LAS float*)(lds + GM_SS);
    const int hh = wave >> 1, mh = wave & 1;
    const int gd_ = gdim_(); int bx_ = bidx_() + 64; if (bx_ >= gd_) bx_ -= gd_;
    for (int u = bx_; u < nunits; u += gd_) {
        int rowbase;
        if (u < 512) rowbase = (u >> 4) * SEQ + (u & 15) * 128; else { const int u2 = u - 512; rowbase = TX + (u2 >> 1) * CTXL + (u2 & 1) * 128; }
        bf16x8 wfr[4][4];
#pragma unroll
        for (int s4 = 0; s4 < 4; ++s4)
#pragma unroll
            for (int mt = 0; mt < 4; ++mt) wfr[s4][mt] = *(const GAS bf16x8*)(gwsb + ((size_t)hh * 128 + 64 * mh + 16 * mt + fr) * 128 + 32 * s4 + 8 * fq);
        { const f32x4 lg = *(const GAS f32x4*)(lng + lane * 4), lb = *(const GAS f32x4*)(lnb + lane * 4);
          const int swz = (lane >> 1) & 3;
          v2u rawa[16];
#pragma unroll
          for (int q = 0; q < 16; ++q) rawa[q] = *(const GAS v2u*)(PX + (size_t)(rowbase + wave * 16 + q) * INW + OFF_GMLP + 256 + lane * 4);
#pragma unroll
          for (int tq = 0; tq < 4; ++tq) { const int tb = wave * 16 + 4 * tq; float o[4][4];
#pragma unroll
              for (int q = 0; q < 4; ++q) { const v2u rq = rawa[4 * tq + q];
                  float v[4] = {bflo(rq.x), bfhi(rq.x), bflo(rq.y), bfhi(rq.y)};
                  const float mean = wave_sum((v[0] + v[1]) + (v[2] + v[3])) * (1.0f / 256.0f); float s2 = 0.f;
#pragma unroll
                  for (int j = 0; j < 4; ++j) { v[j] -= mean; s2 += v[j] * v[j]; }
                  const float rstd = __builtin_amdgcn_rsqf(wave_sum(s2) * (1.0f / 256.0f) + EPS);
                  o[q][0] = v[0] * rstd * lg.x + lb.x; o[q][1] = v[1] * rstd * lg.y + lb.y; o[q][2] = v[2] * rstd * lg.z + lb.z; o[q][3] = v[3] * rstd * lg.w + lb.w; }
              LAS unsigned char* vt = lds + (lane * 4) * GM_VST + (((tb >> 3) ^ swz) << 4) + (tb & 7) * 2;
#pragma unroll
              for (int j = 0; j < 4; ++j) { v2u w; w.x = pk2(o[0][j], o[1][j]); w.y = pk2(o[2][j], o[3][j]); *(LAS v2u*)(vt + j * GM_VST) = w; } } }
        __syncthreads();
        f32x4 acc[4][4];
        v2u uraw[4][4];
#pragma unroll
        for (int mt = 0; mt < 4; ++mt)
#pragma unroll
            for (int nt = 0; nt < 4; ++nt) { acc[mt][nt] = (f32x4){0.f, 0.f, 0.f, 0.f};
                uraw[mt][nt] = *(const GAS v2u*)(PX + (size_t)(rowbase + 64 * mh + 16 * mt + fr) * INW + OFF_GMLP + 64 * hh + 4 * fq + 16 * nt); }
#pragma unroll
        for (int s4 = 0; s4 < 4; ++s4) {
            bf16x8 vf[4];
#pragma unroll
            for (int nt = 0; nt < 4; ++nt) vf[nt] = *(const LAS bf16x8*)(lds + (hh * 64 + 16 * nt + fr) * GM_VST + (((4 * s4 + fq) ^ (((nt & 1) << 1) | (fr >> 3))) << 4));
#pragma unroll
            for (int mt = 0; mt < 4; ++mt)
#pragma unroll
                for (int nt = 0; nt < 4; ++nt) acc[mt][nt] = MFMA16(vf[nt], wfr[s4][mt], acc[mt][nt]);
        }
#pragma unroll
        for (int mt = 0; mt < 4; ++mt) { const int p = 64 * mh + 16 * mt + fr; const float bsv = gbs[hh * 128 + p]; float ss = 0.f;
#pragma unroll
            for (int nt = 0; nt < 4; ++nt) { const v2u raw = uraw[mt][nt];
                acc[mt][nt][0] = bflo(raw.x) * (acc[mt][nt][0] + bsv); acc[mt][nt][1] = bfhi(raw.x) * (acc[mt][nt][1] + bsv);
                acc[mt][nt][2] = bflo(raw.y) * (acc[mt][nt][2] + bsv); acc[mt][nt][3] = bfhi(raw.y) * (acc[mt][nt][3] + bsv);
                ss += (acc[mt][nt][0] * acc[mt][nt][0] + acc[mt][nt][1] * acc[mt][nt][1]) + (acc[mt][nt][2] * acc[mt][nt][2] + acc[mt][nt][3] * acc[mt][nt][3]); }
            ss = xor16_sum(ss); ss = xor32_sum(ss);
            if (fq == 0) ssh[hh * 128 + p] = ss; }
        __syncthreads();
#pragma unroll
        for (int mt = 0; mt < 4; ++mt) { const int p = 64 * mh + 16 * mt + fr; const float tot = ssh[p] + ssh[128 + p] + ssh[256 + p] + ssh[384 + p];
            const float rstd = __builtin_amdgcn_rsqf(tot * (1.0f / 256.0f) + EPS);
#pragma unroll
            for (int nt = 0; nt < 4; ++nt) { const int c0 = 64 * hh + 16 * nt + 4 * fq; const f32x4 gg = *(const GAS f32x4*)(gng + 512 + c0);
                v2u w; w.x = pk2(acc[mt][nt][0] * rstd * gg.x, acc[mt][nt][1] * rstd * gg.y); w.y = pk2(acc[mt][nt][2] * rstd * gg.z, acc[mt][nt][3] * rstd * gg.w);
                *(GAS v2u*)(MIX + (size_t)(rowbase + p) * D + 512 + c0) = w; } }
        __syncthreads();
    }
}

constexpr int PL_HP = 0, PL_Y = 80 * 1024, PL_YST = 528, PL_SS = PL_Y + 64 * PL_YST;
template <int W>
__device__ __forceinline__ void pool_window(const LAS float* hp, LAS unsigned char* yb, int c, int half, int tbase, int Ls) {
    float win[48];
#pragma unroll
    for (int j = 0; j < 48; ++j) win[j] = hp[(half * 32 + j) * 256 + c];
    float S = 0.f;
#pragma unroll
    for (int j = 8 - W; j < 8 + W; ++j) S += win[j];
    if (tbase >= W && tbase + 31 + W <= Ls) {
#pragma unroll
        for (int i = 0; i < 32; ++i) { const float y = S * (1.0f / (2 * W)) - win[i + 8];
            *(LAS unsigned short*)(yb + (half * 32 + i) * PL_YST + c * 2) = (unsigned short)f2bf(y);
            if (i < 31) S += win[i + 8 + W] - win[i + 8 - W]; }
    } else {
#pragma unroll
    for (int i = 0; i < 32; ++i) { const int t = tbase + i; const int cnt = min(t + W, Ls) - max(t - W, 0);
        const float y = S * __builtin_amdgcn_rcpf((float)cnt) - win[i + 8];
        *(LAS unsigned short*)(yb + (half * 32 + i) * PL_YST + c * 2) = (unsigned short)f2bf(y);
        if (i < 31) S += win[i + 8 + W] - win[i + 8 - W]; }
    }
}
__device__ __forceinline__ void pool_mfma(const GAS bf16* PX, GAS bf16* MIX, const GAS bf16* pwT, const GAS float* pscale, const GAS float* gng, LAS unsigned char* lds, int nunits, const int w0_) {
    const int w0 = opq(w0_);
    const int tid = TIDX(w0), wave = w0, lane = tid & 63, fr = lane & 15, fq = lane >> 4;
    LAS float* hp = (LAS float*)(lds + PL_HP); LAS unsigned char* yb = lds + PL_Y; LAS float* ssw = (LAS float*)(lds + PL_SS);
    const int c = tid & 255, half = tid >> 8, gic = c >> 6;
    const int gi = wave >> 1, nh = wave & 1;
    const int gd_ = gdim_(); int bx_ = bidx_() + 64; if (bx_ >= gd_) bx_ -= gd_;
    v2u ra[10];
#define PL_LOAD(uu) do { int rb_, t0_, Ls_; if ((uu) < 1024) { rb_ = ((uu) >> 5) * SEQ; t0_ = ((uu) & 31) * 64; Ls_ = SEQ; } else { const int u2_ = (uu) - 1024; rb_ = TX + (u2_ >> 2) * CTXL; t0_ = (u2_ & 3) * 64; Ls_ = CTXL; } \
        _Pragma("unroll") for (int it = 0; it < 10; ++it) { const int idx = tid + 512 * it, tt = idx >> 6, c4 = (idx & 63) * 4, t = t0_ - 8 + tt; const bool ok = t >= 0 && t < Ls_; \
            ra[it] = *(const GAS v2u*)(PX + (size_t)(rb_ + (ok ? t : t0_)) * INW + OFF_POOL + c4); } } while (0)
    if (bx_ < nunits) PL_LOAD(bx_);
    for (int u = bx_; u < nunits; u += gd_) {
        int rowbase, t0, Ls;
        if (u < 1024) { rowbase = (u >> 5) * SEQ; t0 = (u & 31) * 64; Ls = SEQ; } else { const int u2 = u - 1024; rowbase = TX + (u2 >> 2) * CTXL; t0 = (u2 & 3) * 64; Ls = CTXL; }
        {
#pragma unroll
          for (int it = 0; it < 10; ++it) { const int idx = tid + 512 * it, tt = idx >> 6, c4 = (idx & 63) * 4, t = t0 - 8 + tt; const bool ok = t >= 0 && t < Ls;
              const v2u rv = ok ? ra[it] : (v2u){0u, 0u};
              *(LAS f32x4*)(hp + tt * 256 + c4) = (f32x4){bflo(rv.x), bfhi(rv.x), bflo(rv.y), bfhi(rv.y)}; } }
        if (u + gd_ < nunits) PL_LOAD(u + gd_);
        bf16x8 wf[2][2];
#pragma unroll
        for (int nt = 0; nt < 2; ++nt)
#pragma unroll
            for (int s2 = 0; s2 < 2; ++s2) wf[nt][s2] = *(const GAS bf16x8*)(pwT + ((size_t)gi * 64 + 32 * nh + 16 * nt + fr) * 64 + 32 * s2 + 8 * fq);
        __syncthreads();
        { const int tbase = t0 + half * 32;
          if (gic == 0) pool_window<1>(hp, yb, c, half, tbase, Ls); else if (gic == 1) pool_window<2>(hp, yb, c, half, tbase, Ls);
          else if (gic == 2) pool_window<4>(hp, yb, c, half, tbase, Ls); else pool_window<8>(hp, yb, c, half, tbase, Ls); }
        __syncthreads();
        f32x4 acc[2][4];
#pragma unroll
        for (int nt = 0; nt < 2; ++nt)
#pragma unroll
            for (int tt = 0; tt < 4; ++tt) acc[nt][tt] = (f32x4){0.f, 0.f, 0.f, 0.f};
#pragma unroll
        for (int s2 = 0; s2 < 2; ++s2) {
            bf16x8 yf[4];
#pragma unroll
            for (int tt = 0; tt < 4; ++tt) yf[tt] = *(const LAS bf16x8*)(yb + (16 * tt + fr) * PL_YST + (gi * 64 + 32 * s2 + 8 * fq) * 2);
#pragma unroll
            for (int nt = 0; nt < 2; ++nt)
#pragma unroll
                for (int tt = 0; tt < 4; ++tt) acc[nt][tt] = MFMA16(wf[nt][s2], yf[tt], acc[nt][tt]);
        }
#pragma unroll
        for (int nt = 0; nt < 2; ++nt) { const f32x4 ps = *(const GAS f32x4*)(pscale + 64 * gi + 32 * nh + 16 * nt + 4 * fq);
#pragma unroll
            for (int tt = 0; tt < 4; ++tt) { acc[nt][tt][0] *= ps.x; acc[nt][tt][1] *= ps.y; acc[nt][tt][2] *= ps.z; acc[nt][tt][3] *= ps.w; } }
#pragma unroll
        for (int tt = 0; tt < 4; ++tt) { float ss = 0.f;
#pragma unroll
            for (int nt = 0; nt < 2; ++nt)
#pragma unroll
                for (int rg = 0; rg < 4; ++rg) ss += acc[nt][tt][rg] * acc[nt][tt][rg];
            ss = xor16_sum(ss); ss = xor32_sum(ss);
            if (fq == 0) ssw[wave * 64 + 16 * tt + fr] = ss; }
        __syncthreads();
#pragma unroll
        for (int tt = 0; tt < 4; ++tt) { const int tk = 16 * tt + fr; float tot = 0.f;
#pragma unroll
            for (int w8 = 0; w8 < 8; ++w8) tot += ssw[w8 * 64 + tk];
            const float rstd = __builtin_amdgcn_rsqf(tot * (1.0f / 256.0f) + EPS);
#pragma unroll
            for (int nt = 0; nt < 2; ++nt) { const int n0 = 64 * gi + 32 * nh + 16 * nt + 4 * fq; const f32x4 gg = *(const GAS f32x4*)(gng + 768 + n0);
                v2u w; w.x = pk2(acc[nt][tt][0] * rstd * gg.x, acc[nt][tt][1] * rstd * gg.y); w.y = pk2(acc[nt][tt][2] * rstd * gg.z, acc[nt][tt][3] * rstd * gg.w);
                *(GAS v2u*)(MIX + (size_t)(rowbase + t0 + tk) * D + 768 + n0) = w; } }
        __syncthreads();
    }
#undef PL_LOAD
}

__device__ __forceinline__ unsigned long long ldptr(const volatile LAS unsigned long long* PT, int i) {
    const unsigned long long v = PT[i];
    const unsigned lo = __builtin_amdgcn_readfirstlane((unsigned)v), hi = __builtin_amdgcn_readfirstlane((unsigned)(v >> 32));
    return ((unsigned long long)hi << 32) | lo;
}
#define INP(i) ((const GAS float*)ldptr(PT, (i)))
#define OUTP() ((GAS float*)ldptr(PT, 30))
#define WSP() ((GAS unsigned char*)ldptr(PT, 31))

__global__ void __launch_bounds__(512, 2) __attribute__((amdgpu_waves_per_eu(2, 2))) fwd(Args args) {
    extern __shared__ __attribute__((aligned(16))) unsigned char lds_raw[];
    LAS unsigned char* lds = (LAS unsigned char*)lds_raw;
    volatile LAS unsigned* MISC = (volatile LAS unsigned*)(lds + MISC_OFF);
    volatile LAS unsigned long long* PT = (volatile LAS unsigned long long*)(lds + MISC_OFF + MO_PT);
#define PHASE_IDS() const int wave = opq(wave0); const int tid = TIDX(wave), lane = tid & 63; const int BX = bidx_(), G = gdim_(); (void)BX; const int gw = BX * 8 + wave, NGW = G * 8; (void)gw; (void)NGW; (void)lane
    const int lo = args.ph_lo, hi = args.ph_hi;
    const int wave0 = __builtin_amdgcn_readfirstlane((int)threadIdx.x >> 6);
    { const int tid = threadIdx.x;
      if (tid < 4) MISC[tid] = 0u;
      if (tid < 30) PT[tid] = (unsigned long long)args.in[tid];
      if (tid == 30) PT[30] = (unsigned long long)args.out;
      if (tid == 31) PT[31] = (unsigned long long)args.ws; }
    __syncthreads();
    XcdBarrier bar; bar.bar = (GAS unsigned*)(WSP() + WS_CTL) + CW_BAR; bar.x = 0; bar.st = MISC;
    if (hi - lo > 1) bar = xcd_barrier_post((GAS unsigned*)(WSP() + WS_CTL) + CW_BAR, MISC, wave0);
#ifndef PH_MASK
#define PH_MASK 0xFFFFFFFFu
#endif
#define IN(k) (((PH_MASK >> ((k) > 9 ? (k) - 9 : (k))) & 1u) && lo <= (k) && (k) < hi)
#define SEAM(k) do { if (IN(k) && IN((k) + 1)) xcd_barrier(bar, wave0); } while (0)

    if (IN(0)) {
            PHASE_IDS();
        GAS unsigned char* ws = WSP();
        {
            GAS bf16* WIN_T = (GAS bf16*)(ws + WS_WIN); GAS bf16* WOUT_T = (GAS bf16*)(ws + WS_WOUT); GAS unsigned char* W1_T = ws + WS_W1; GAS unsigned char* W2_T = ws + WS_W2;
            const GAS float* w_in = INP(I_WIN); const GAS float* w_out = INP(I_WOUT); const GAS float* w1 = INP(I_W1); const GAS float* w2 = INP(I_W2);
            LAS float* scr = (LAS float*)(lds + wave * 16384);
            for (int it = gw; it < 1024; it += NGW) {
                int r = it;
                { const int mi = r / 512; p0_transpose_item(w_out + (size_t)mi * 1024 * 1024, 1024, 1024, WOUT_T + (size_t)mi * 1024 * 1024, scr, r % 512, lane); }
            }
            {
                constexpr int NF = 49152 + 896; GAS unsigned char* WIN8_T = ws + WS_WIN;
                f32x4 la[16], lb[16];
                int r = gw; P0Item ia = p0_f8_decode(r < NF ? r : 0, w1, w2, w_in, W1_T, W2_T, WIN8_T, lane), ib = ia;
                if (r < NF) p0_f8_load(ia, la);
#pragma unroll 1
                while (r < NF) {
                    int rn = r + NGW;
                    if (rn < NF) { ib = p0_f8_decode(rn, w1, w2, w_in, W1_T, W2_T, WIN8_T, lane); p0_f8_load(ib, lb); }
                    p0_f8_store(ia.dst, la);
                    r = rn; if (r >= NF) break;
                    rn = r + NGW;
                    if (rn < NF) { ia = p0_f8_decode(rn, w1, w2, w_in, W1_T, W2_T, WIN8_T, lane); p0_f8_load(ia, la); }
                    p0_f8_store(ib.dst, lb);
                    r = rn;
                }
            }
        }
        {
            GAS bf16* GWSB = (GAS bf16*)(ws + WS_GWSB); GAS bf16* CPWT = (GAS bf16*)(ws + WS_CPWT); GAS bf16* PWT = (GAS bf16*)(ws + WS_PWT);
            const GAS float* gws = INP(I_GWS); const GAS float* cpw = INP(I_CPW); const GAS float* plw = INP(I_POOLW);
            const int gt = BX * 512 + tid, GT = G * 512;
            for (int i = gt; i < 2 * 4 * 128 * 128; i += GT) GWSB[i] = (bf16)f2bf(gws[i]);
            for (int i = gt; i < 2 * 256 * 256; i += GT) { const int l2 = i >> 16, n = (i >> 8) & 255, c = i & 255; CPWT[i] = (bf16)f2bf(cpw[(size_t)l2 * 65536 + c * 256 + n]); }
            for (int i = gt; i < 2 * 4 * 64 * 64; i += GT) { const int lg = i >> 12, n = (i >> 6) & 63, k = i & 63; PWT[i] = (bf16)f2bf(plw[(size_t)lg * 4096 + k * 64 + n]); }
        }
        {
            GAS float* ROPE = (GAS float*)(ws + WS_ROPE);
            for (int idx = BX * 512 + tid; idx < 1024; idx += G * 512) { const int pos = idx >> 4, i = idx & 15;
                const float inv = powf(10000.0f, -(float)i / 16.0f); const float ang = (float)pos * inv; ROPE[idx] = cosf(ang); ROPE[1024 + idx] = sinf(ang); }
        }
        __syncthreads();
        {
            GAS float* MOD = (GAS float*)(ws + WS_MOD);
            const GAS float* cc = INP(I_C); const GAS float* cctx = INP(I_CCTX); const GAS float* adaw = INP(I_ADAW); const GAS float* adab = INP(I_ADAB);
            LAS float* sc = (LAS float*)lds;
            LAS float* scx = (LAS float*)(lds + MISC_OFF + MO_TMP);
            LAS float* red = (LAS float*)lds;
            const int fr = lane & 15, fk = lane >> 4;
            for (int item = BX; item < 256; item += G) {
                const int l = item >> 7, jb = (item & 127) * 48;
                const GAS float* aw = adaw + (size_t)l * 1024 * 6144 + jb;
                float bw[32][3];
                { const unsigned loff = (unsigned)(fk * 6144 + fr); const GAS float* awk = aw + (size_t)wave * 128 * 6144;
#pragma unroll
                  for (int st = 0; st < 32; ++st) { const GAS float* rowp = awk + (size_t)st * 4 * 6144;
#pragma unroll
                      for (int nt = 0; nt < 3; ++nt) bw[st][nt] = __builtin_nontemporal_load(rowp + loff + 16 * nt); } }
                __syncthreads();
                for (int idx = tid; idx < 33 * 1024; idx += 512) { const int bi = idx >> 10, k = idx & 1023; const float v = (bi < 32) ? cc[idx] : cctx[k]; const float sv = v * sigmoidf_(v);
                    if (bi < 32) sc[bi * 1024 + (k ^ ((bi & 7) << 2))] = sv; else scx[k] = sv; }
                __syncthreads();
                f32x4 dm[3][3];
#pragma unroll
                for (int mt = 0; mt < 3; ++mt)
#pragma unroll
                    for (int nt = 0; nt < 3; ++nt) dm[mt][nt] = (f32x4){0.f, 0.f, 0.f, 0.f};
#pragma unroll
                for (int st = 0; st < 32; ++st) { const int k = wave * 128 + 4 * st + fk;
                    const float a0 = sc[fr * 1024 + (k ^ ((fr & 7) << 2))], a1 = sc[(16 + fr) * 1024 + (k ^ ((fr & 7) << 2))];
                    const float ax = scx[k]; const float a2 = (fr == 0) ? ax : 0.f;
#pragma unroll
                    for (int nt = 0; nt < 3; ++nt) {
                        dm[0][nt] = __builtin_amdgcn_mfma_f32_16x16x4f32(a0, bw[st][nt], dm[0][nt], 0, 0, 0);
                        dm[1][nt] = __builtin_amdgcn_mfma_f32_16x16x4f32(a1, bw[st][nt], dm[1][nt], 0, 0, 0);
                        dm[2][nt] = __builtin_amdgcn_mfma_f32_16x16x4f32(a2, bw[st][nt], dm[2][nt], 0, 0, 0); } }
                __syncthreads();
#pragma unroll
                for (int mt = 0; mt < 3; ++mt)
#pragma unroll
                    for (int nt = 0; nt < 3; ++nt)
#pragma unroll
                        for (int r = 0; r < 4; ++r) red[(wave * 48 + 16 * mt + 4 * fk + r) * 48 + 16 * nt + fr] = dm[mt][nt][r];
                __syncthreads();
                for (int o = tid; o < 33 * 48; o += 512) { const int i = o / 48, c2 = o % 48; float sacc = adab[l * 6144 + jb + c2];
#pragma unroll
                    for (int k8 = 0; k8 < 8; ++k8) sacc += red[(k8 * 48 + i) * 48 + c2];
                    MOD[((size_t)l * 33 + i) * 6144 + jb + c2] = sacc; }
            }
            __syncthreads();
        }
    }
    SEAM(0);

#pragma unroll
    for (int l = 0; l < 2; ++l) {
        const int pb = 1 + 9 * l;
        const int ntok = (l == 0) ? TT : TX;
        if (IN(pb)) {
            PHASE_IDS();
            GAS unsigned char* ws = WSP(); GAS float* out = OUTP();
            const GAS float* MOD = (const GAS float*)(ws + WS_MOD); const GAS float* modl = MOD + (size_t)l * 33 * 6144;
            GAS float* CTXR = (GAS float*)(ws + WS_CTXR); GAS bf16* HX = (GAS bf16*)(ws + WS_HX); const GAS unsigned char* YB = ws + WS_R2; GAS bf16* XB = (GAS bf16*)(ws + WS_XB);
            const GAS int* SLOT = (const GAS int*)(ws + WS_ROUTE + RT_SLOT); const GAS float* GATE = (const GAS float*)(ws + WS_ROUTE + RT_GATE);
            const GAS float* g = INP(I_N1G) + l * D; const GAS float* xin = INP(I_X); const GAS float* cin = INP(I_CTX);
            for (int ra = gw; ra < TT; ra += 2 * NGW) {
                const int rb = (ra + NGW < TT) ? ra + NGW : ra;
                const bool isxa = ra < TX, isxb = rb < TX; const int bia = isxa ? (ra >> 11) : 32, bib = isxb ? (rb >> 11) : 32;
                f32x4 va[4], vb[4], h[4];
                if (l == 0) {
                    load_row<false>(isxa ? xin + (size_t)ra * D : cin + (size_t)(ra - TX) * D, ra, nullptr, nullptr, nullptr, nullptr, lane, va);
                    load_row<false>(isxb ? xin + (size_t)rb * D : cin + (size_t)(rb - TX) * D, rb, nullptr, nullptr, nullptr, nullptr, lane, vb);
                } else {
                    load_row2<!DBG_SKIP_MOE>(isxa ? (const GAS void*)(XB + (size_t)ra * D) : (const GAS void*)(CTXR + (size_t)(ra - TX) * D), isxa, isxb ? (const GAS void*)(XB + (size_t)rb * D) : (const GAS void*)(CTXR + (size_t)(rb - TX) * D), isxb, ra, rb, SLOT, GATE, YB,
                                             MOD + (size_t)(bia * 6 + 5) * D, MOD + (size_t)(bib * 6 + 5) * D, lane, va, vb);
                    if (isxa) st_row_bf16(XB + (size_t)ra * D, lane, va);
                    if (isxb && rb != ra) st_row_bf16(XB + (size_t)rb * D, lane, vb); }
                const float rsa = row_rstd(va), rsb = row_rstd(vb);
                mod_store_fp8(va, rsa, g, modl + (size_t)(bia * 6 + 1) * D, modl + (size_t)(bia * 6 + 0) * D, (GAS unsigned char*)HX + (size_t)ra * D, lane);
                mod_store_fp8(vb, rsb, g, modl + (size_t)(bib * 6 + 1) * D, modl + (size_t)(bib * 6 + 0) * D, (GAS unsigned char*)HX + (size_t)rb * D, lane);
            }
        }
        if (IN(pb)) {
            PHASE_IDS();
            GAS unsigned char* ws = WSP();
            const GAS float* modl = (const GAS float*)(ws + WS_MOD) + (size_t)l * 33 * 6144; const GAS float* g = INP(I_N2G) + l * D; const GAS float* rw = INP(I_RW) + (size_t)l * 1024 * 32; const GAS float* rb = INP(I_RB) + l * 32;
            GAS v4u* BMF = (GAS v4u*)(ws + WS_BMF) + (size_t)l * 33 * 32 * 2 * 64 * 2; GAS float* CVEC = (GAS float*)(ws + WS_CVEC) + l * 33 * 32;
            for (int idx = BX * 512 + tid; idx < 33 * 32 * 2 * 64; idx += G * 512) {
                const int lf = idx & 63, nt = (idx >> 6) & 1, s4 = (idx >> 7) & 31, bi = idx >> 12;
                const int e = 16 * nt + (lf & 15), k0 = 32 * s4 + 8 * (lf >> 4);
                const GAS float* scp = modl + (size_t)(bi * 6 + 4) * D;
                float v[8]; unsigned hb[8];
#pragma unroll
                for (int j = 0; j < 8; ++j) { v[j] = g[k0 + j] * (1.0f + scp[k0 + j]) * rw[(k0 + j) * 32 + e]; hb[j] = f2bf(v[j]); }
                v4u hw, lw;
                hw.x = hb[0] | (hb[1] << 16); hw.y = hb[2] | (hb[3] << 16); hw.z = hb[4] | (hb[5] << 16); hw.w = hb[6] | (hb[7] << 16);
                lw.x = pk2(v[0] - bflo(hb[0]), v[1] - bflo(hb[1])); lw.y = pk2(v[2] - bflo(hb[2]), v[3] - bflo(hb[3])); lw.z = pk2(v[4] - bflo(hb[4]), v[5] - bflo(hb[5])); lw.w = pk2(v[6] - bflo(hb[6]), v[7] - bflo(hb[7]));
                BMF[(size_t)idx * 2] = hw; BMF[(size_t)idx * 2 + 1] = lw;
            }
            for (int task = gw; task < 33 * 32; task += NGW) { const int bi = task >> 5, e = task & 31; const GAS float* shp = modl + (size_t)(bi * 6 + 3) * D; float a = 0.f;
                for (int k = lane; k < 1024; k += 64) a += shp[k] * rw[k * 32 + e];
                a = wave_sum(a); if (lane == 0) CVEC[task] = a + rb[e]; }
        }
        SEAM(pb);
        if (IN(pb + 1)) {
            const int BX = bidx_(), G = gdim_();
            GAS unsigned char* ws = WSP();
            ProbIn P{ws + WS_HX, ws + WS_WIN + (size_t)l * 1792 * 1024, (GAS bf16*)(ws + WS_R1), l, BX, G, (const GAS float*)(ws + WS_ROPE)};
            pg8::gemm_phase<ProbIn>(lds, P, wave0);
        }
        SEAM(pb + 1);
#ifndef MIXSEL
#define MIXSEL 15
#endif
        if (IN(pb + 3)) {
            const int BX = bidx_(), G = gdim_(); (void)BX; (void)G;
            if (MIXSEL == 0) { GAS v4u* mx = (GAS v4u*)(WSP() + WS_R1 + 252 * MiB); for (size_t i = (size_t)BX * 512 + TIDX(wave0); i < (size_t)TT * D / 8; i += (size_t)G * 512) mx[i] = (v4u){0u, 0u, 0u, 0u}; }
            if (MIXSEL & 1) { GAS unsigned char* ws = WSP(); attn_mfma((const GAS bf16*)(ws + WS_R1), (GAS bf16*)(ws + WS_R1 + 252 * MiB), INP(I_SINK) + l * 4, INP(I_GNG) + l * D, lds, l == 0 ? 576 : 512, wave0); }
            __syncthreads();
            if (MIXSEL & 2) { GAS unsigned char* ws = WSP(); conv_mfma((const GAS bf16*)(ws + WS_R1), (GAS bf16*)(ws + WS_R1 + 252 * MiB), INP(I_DWW) + l * 31 * 256, INP(I_DWB) + l * 256, INP(I_CLNG) + l * 256, INP(I_CLNB) + l * 256, (const GAS bf16*)(ws + WS_CPWT) + (size_t)l * 65536, INP(I_GNG) + l * D, lds, l == 0 ? 1152 : 1024, wave0); }
            __syncthreads();
            if (MIXSEL & 4) { GAS unsigned char* ws = WSP(); gmlp_mfma((const GAS bf16*)(ws + WS_R1), (GAS bf16*)(ws + WS_R1 + 252 * MiB), INP(I_GLNG) + l * 256, INP(I_GLNB) + l * 256, (const GAS bf16*)(ws + WS_GWSB) + (size_t)l * 4 * 128 * 128, INP(I_GBS) + l * 512, INP(I_GNG) + l * D, lds, l == 0 ? 576 : 512, wave0); }
            __syncthreads();
            if (MIXSEL & 8) { GAS unsigned char* ws = WSP(); pool_mfma((const GAS bf16*)(ws + WS_R1), (GAS bf16*)(ws + WS_R1 + 252 * MiB), (const GAS bf16*)(ws + WS_PWT) + (size_t)l * 4 * 64 * 64, INP(I_PSCALE) + l * 256, INP(I_GNG) + l * D, lds, l == 0 ? 1152 : 1024, wave0); }
            __syncthreads();
        }
        SEAM(pb + 3);
        if (IN(pb + 4)) {
            const int BX = bidx_(), G = gdim_();
            GAS unsigned char* ws = WSP(); GAS float* out = OUTP();
            ProbOut P{(const GAS bf16*)(ws + WS_R1 + 252 * MiB), (const GAS bf16*)(ws + WS_WOUT) + (size_t)l * 1024 * 1024, INP(I_X), INP(I_CTX), (GAS bf16*)(ws + WS_XB), (GAS float*)(ws + WS_CTXR), (const GAS float*)(ws + WS_MOD) + (size_t)l * 33 * 6144, l == 0 ? 288 : 256, l, BX, G};
            pg8::gemm_phase<ProbOut>(lds, P, wave0);
        }
        SEAM(pb + 4);
        if (IN(pb + 5)) {
            PHASE_IDS();
            GAS unsigned char* ws = WSP(); const GAS bf16* XB = (const GAS bf16*)(ws + WS_XB);
            const GAS float* modl = (const GAS float*)(ws + WS_MOD) + (size_t)l * 33 * 6144; const GAS float* CTXR = (const GAS float*)(ws + WS_CTXR); GAS unsigned char* HX8 = ws + WS_HX;
            GAS int* TOPI = (GAS int*)(ws + WS_ROUTE + RT_TOPI); GAS float* GATE = (GAS float*)(ws + WS_ROUTE + RT_GATE); GAS int* LPOS = (GAS int*)(ws + WS_ROUTE + RT_LPOS); GAS int* WVCNT = (GAS int*)(ws + WS_ROUTE + RT_WVCNT);
            const GAS v4u* BMF = (const GAS v4u*)(ws + WS_BMF) + (size_t)l * 33 * 32 * 2 * 64 * 2; const GAS float* CVEC = (const GAS float*)(ws + WS_CVEC) + l * 33 * 32;
            const GAS float* g = INP(I_N2G) + l * D;
            const int tpw = ntok / G, ntile = tpw / 16;
            const int tok = lane & 15, kq = lane >> 4;
            int cnt = 0;
            const int xpw = TX / G, cpw = (ntok - TX) / G, nxt_ = xpw / 16;
            const int bi0 = (BX * xpw) >> 11;
            { const GAS v4u* src = BMF + (size_t)bi0 * 4096 * 2;
#pragma unroll 4
              for (int i = 0; i < 8; ++i) { const int idx = tid + 512 * i; const v4u vh = src[idx * 2], vl = src[idx * 2 + 1]; *(LAS v4u*)(lds + idx * 16) = vh; *(LAS v4u*)(lds + 65536 + idx * 16) = vl; } }
            LAS float* gsl = (LAS float*)(lds + MISC_OFF + MO_TMP); LAS float* s0l = gsl + 1024;
            { const GAS float* scp0 = modl + (size_t)(bi0 * 6 + 4) * D; const GAS float* shp0 = modl + (size_t)(bi0 * 6 + 3) * D;
              for (int idx = tid; idx < 1024; idx += 512) { gsl[idx] = g[idx] * (scp0[idx] + 1.0f); s0l[idx] = shp0[idx]; } }
            __syncthreads();
            for (int ti_ = 0; ; ++ti_) { const int tile = n2_tile(wave, ti_, ntile); if (tile < 0) break;
                const int r0 = (tile < nxt_) ? (BX * xpw + tile * 16) : (TX + BX * cpw + (tile - nxt_) * 16); const bool isx = r0 < TX; const int bi = isx ? (r0 >> 11) : 32;
                const GAS float* xr = CTXR + (size_t)(isx ? 0 : (r0 - TX)) * D;
                const GAS bf16* xrb = XB + (size_t)(isx ? r0 : 0) * D;
                f32x4 acc0 = (f32x4){0.f, 0.f, 0.f, 0.f}, acc1 = (f32x4){0.f, 0.f, 0.f, 0.f}, accq = (f32x4){0.f, 0.f, 0.f, 0.f}; float ssp = 0.f;
                const bool onepass = isx && bi == bi0;
                if (onepass) {
                    const GAS bf16* xp = xrb + (unsigned)(tok * D + 8 * kq);
                    v4u hws[32];
#pragma unroll
                    for (int s4 = 0; s4 < 32; ++s4) hws[s4] = *(const GAS v4u*)(xp + 32 * s4);
#pragma unroll
                    for (int s4 = 0; s4 < 32; ++s4) { const bf16x8 xh = __builtin_bit_cast(bf16x8, hws[s4]); accq = __builtin_amdgcn_mfma_f32_16x16x32_bf16(xh, xh, accq, 0, 0, 0); }
                    float rl;
                    { const int tr = tok & 3; const float dv = tr == 0 ? accq[0] : tr == 1 ? accq[1] : tr == 2 ? accq[2] : accq[3];
                      float sq = (kq == (tok >> 2)) ? dv : 0.f; sq = xor16_sum(sq); sq = xor32_sum(sq); rl = __builtin_amdgcn_rsqf(sq * (1.0f / D) + EPS); }
#pragma unroll
                    for (int s4 = 0; s4 < 32; ++s4) {
                        const v4u hw = hws[s4];
                        const bf16x8 xh = __builtin_bit_cast(bf16x8, hw);
                        const LAS unsigned char* lb = lds + ((s4 * 2) * 64 + lane) * 16;
                        const v4u b0h = *(const LAS v4u*)lb, b1h = *(const LAS v4u*)(lb + 1024), b0l = *(const LAS v4u*)(lb + 65536), b1l = *(const LAS v4u*)(lb + 65536 + 1024);
                        acc0 = __builtin_amdgcn_mfma_f32_16x16x32_bf16(xh, __builtin_bit_cast(bf16x8, b0h), acc0, 0, 0, 0);
                        acc0 = __builtin_amdgcn_mfma_f32_16x16x32_bf16(xh, __builtin_bit_cast(bf16x8, b0l), acc0, 0, 0, 0);
                        acc1 = __builtin_amdgcn_mfma_f32_16x16x32_bf16(xh, __builtin_bit_cast(bf16x8, b1h), acc1, 0, 0, 0);
                        acc1 = __builtin_amdgcn_mfma_f32_16x16x32_bf16(xh, __builtin_bit_cast(bf16x8, b1l), acc1, 0, 0, 0);
                        const int k0 = 32 * s4 + 8 * kq;
                        const f32x4 gA = *(const LAS f32x4*)(gsl + k0) * rl, gB = *(const LAS f32x4*)(gsl + k0 + 4) * rl, sA = *(const LAS f32x4*)(s0l + k0), sB = *(const LAS f32x4*)(s0l + k0 + 4);
                        const f32x4 va = (f32x4){bflo(hw.x), bfhi(hw.x), bflo(hw.y), bfhi(hw.y)}, vb = (f32x4){bflo(hw.z), bfhi(hw.z), bflo(hw.w), bfhi(hw.w)};
                        const f32x4 ha = va * gA + sA, hb = vb * gB + sB;
                        v2u o; o.x = pk4_fp8(ha.x, ha.y, ha.z, ha.w); o.y = pk4_fp8(hb.x, hb.y, hb.z, hb.w);
                        *(GAS v2u*)(HX8 + (unsigned)((r0 + tok) * D + k0)) = o;
                    }
                } else if (isx) {
                    int lo_ = lane; asm volatile("" : "+v"(lo_)); const int tok = lo_ & 15, kq = lo_ >> 4;
                    const GAS bf16* xp = xrb + (size_t)tok * D + 8 * kq; const GAS v4u* bp = BMF + (size_t)bi * 32 * 2 * 64 * 2 + lo_ * 2;
#pragma unroll 8
                    for (int s4 = 0; s4 < 32; ++s4) {
                        const v4u hw = *(const GAS v4u*)(xp + 32 * s4);
                        const bf16x8 xh = __builtin_bit_cast(bf16x8, hw);
                        accq = __builtin_amdgcn_mfma_f32_16x16x32_bf16(xh, xh, accq, 0, 0, 0);
                        const v4u b0h = bp[(s4 * 2 + 0) * 128], b0l = bp[(s4 * 2 + 0) * 128 + 1], b1h = bp[(s4 * 2 + 1) * 128], b1l = bp[(s4 * 2 + 1) * 128 + 1];
                        acc0 = __builtin_amdgcn_mfma_f32_16x16x32_bf16(xh, __builtin_bit_cast(bf16x8, b0h), acc0, 0, 0, 0);
                        acc0 = __builtin_amdgcn_mfma_f32_16x16x32_bf16(xh, __builtin_bit_cast(bf16x8, b0l), acc0, 0, 0, 0);
                        acc1 = __builtin_amdgcn_mfma_f32_16x16x32_bf16(xh, __builtin_bit_cast(bf16x8, b1h), acc1, 0, 0, 0);
                        acc1 = __builtin_amdgcn_mfma_f32_16x16x32_bf16(xh, __builtin_bit_cast(bf16x8, b1l), acc1, 0, 0, 0);
                    }
                } else {
                int lo_ = lane; asm volatile("" : "+v"(lo_)); const int tok = lo_ & 15, kq = lo_ >> 4;
                const GAS float* xp = xr + (size_t)tok * D + 8 * kq; const GAS v4u* bp = BMF + (size_t)bi * 32 * 2 * 64 * 2 + lo_ * 2;
#define N2_CTX_STEP(B0H, B0L, B1H, B1L) { \
                    const f32x4 xa = *(const GAS f32x4*)(xp + 32 * s4), xb = *(const GAS f32x4*)(xp + 32 * s4 + 4); \
                    ssp += (xa.x * xa.x + xa.y * xa.y) + (xa.z * xa.z + xa.w * xa.w) + (xb.x * xb.x + xb.y * xb.y) + (xb.z * xb.z + xb.w * xb.w); \
                    v4u hw; hw.x = cvt_pk_bf16(xa.x, xa.y); hw.y = cvt_pk_bf16(xa.z, xa.w); hw.z = cvt_pk_bf16(xb.x, xb.y); hw.w = cvt_pk_bf16(xb.z, xb.w); \
                    v4u lw; lw.x = cvt_pk_bf16(xa.x - bflo(hw.x), xa.y - bfhi(hw.x)); lw.y = cvt_pk_bf16(xa.z - bflo(hw.y), xa.w - bfhi(hw.y)); \
                    lw.z = cvt_pk_bf16(xb.x - bflo(hw.z), xb.y - bfhi(hw.z)); lw.w = cvt_pk_bf16(xb.z - bflo(hw.w), xb.w - bfhi(hw.w)); \
                    const bf16x8 xh = __builtin_bit_cast(bf16x8, hw), xl = __builtin_bit_cast(bf16x8, lw); \
                    const v4u b0h = (B0H), b0l = (B0L), b1h = (B1H), b1l = (B1L); \
                    acc0 = __builtin_amdgcn_mfma_f32_16x16x32_bf16(xh, __builtin_bit_cast(bf16x8, b0h), acc0, 0, 0, 0); \
                    acc0 = __builtin_amdgcn_mfma_f32_16x16x32_bf16(xl, __builtin_bit_cast(bf16x8, b0h), acc0, 0, 0, 0); \
                    acc0 = __builtin_amdgcn_mfma_f32_16x16x32_bf16(xh, __builtin_bit_cast(bf16x8, b0l), acc0, 0, 0, 0); \
                    acc1 = __builtin_amdgcn_mfma_f32_16x16x32_bf16(xh, __builtin_bit_cast(bf16x8, b1h), acc1, 0, 0, 0); \
                    acc1 = __builtin_amdgcn_mfma_f32_16x16x32_bf16(xl, __builtin_bit_cast(bf16x8, b1h), acc1, 0, 0, 0); \
                    acc1 = __builtin_amdgcn_mfma_f32_16x16x32_bf16(xh, __builtin_bit_cast(bf16x8, b1l), acc1, 0, 0, 0); }
                if (bi == bi0) {
#pragma unroll 4
                    for (int s4 = 0; s4 < 32; ++s4) { const LAS unsigned char* lb = lds + ((s4 * 2) * 64 + lo_) * 16;
                        N2_CTX_STEP(*(const LAS v4u*)lb, *(const LAS v4u*)(lb + 65536), *(const LAS v4u*)(lb + 1024), *(const LAS v4u*)(lb + 65536 + 1024)) }
                } else {
#pragma unroll 8
                    for (int s4 = 0; s4 < 32; ++s4) N2_CTX_STEP(bp[(s4 * 2 + 0) * 128], bp[(s4 * 2 + 0) * 128 + 1], bp[(s4 * 2 + 1) * 128], bp[(s4 * 2 + 1) * 128 + 1])
                }
#undef N2_CTX_STEP
                }
                if (isx) { const int tr = tok & 3; const float dv = tr == 0 ? accq[0] : tr == 1 ? accq[1] : tr == 2 ? accq[2] : accq[3];
                    ssp = (kq == (tok >> 2)) ? dv : 0.f; }
                ssp = xor16_sum(ssp); ssp = xor32_sum(ssp);
                const float rstd_l = __builtin_amdgcn_rsqf(ssp * (1.0f / D) + EPS);
                const float cv0 = CVEC[bi * 32 + tok], cv1 = CVEC[bi * 32 + 16 + tok];
                float lg0[4], lg1[4];
#pragma unroll
                for (int rg = 0; rg < 4; ++rg) { const float rs = __int_as_float(__builtin_amdgcn_ds_bpermute((4 * kq + rg) << 2, __float_as_int(rstd_l))); lg0[rg] = acc0[rg] * rs + cv0; lg1[rg] = acc1[rg] * rs + cv1; }
                int ti[4][4]; float tv[4][4];
#pragma unroll
                for (int k = 0; k < 4; ++k)
#pragma unroll
                    for (int rg = 0; rg < 4; ++rg) {
                        float bv = fmaxf(lg0[rg], lg1[rg]);
                        bv = fmaxf(bv, dpp_f<0xB1>(bv)); bv = fmaxf(bv, dpp_f<0x4E>(bv)); bv = fmaxf(bv, dpp_f<0x124>(bv)); bv = fmaxf(bv, dpp_f<0x128>(bv));
                        int bidx = (lg0[rg] == bv) ? tok : ((lg1[rg] == bv) ? 16 + tok : 64);
                        bidx = min(bidx, dpp_i<0xB1>(bidx)); bidx = min(bidx, dpp_i<0x4E>(bidx)); bidx = min(bidx, dpp_i<0x124>(bidx)); bidx = min(bidx, dpp_i<0x128>(bidx));
                        tv[rg][k] = bv; ti[rg][k] = bidx; if (bidx == tok) lg0[rg] = -3.0e38f; if (bidx == 16 + tok) lg1[rg] = -3.0e38f;
                    }
#pragma unroll
                for (int rg = 0; rg < 4; ++rg) { float ex[4], sum = 0.f;
#pragma unroll
                    for (int k = 0; k < 4; ++k) { ex[k] = __expf(tv[rg][k] - tv[rg][0]); sum += ex[k]; }
                    const float isum = __builtin_amdgcn_rcpf(sum); const int r = r0 + 4 * kq + rg;
#pragma unroll
                    for (int k = 0; k < 4; ++k) if (tok == k) { TOPI[r * 4 + k] = ti[rg][k]; GATE[r * 4 + k] = ex[k] * isum; } }
                int mypos = 0;
                { int myE;
                  { const int rsel = (lane >> 2) & 3, ksel = lane & 3; int er[4];
#pragma unroll
                    for (int rg = 0; rg < 4; ++rg) er[rg] = ksel == 0 ? ti[rg][0] : ksel == 1 ? ti[rg][1] : ksel == 2 ? ti[rg][2] : ti[rg][3];
                    myE = rsel == 0 ? er[0] : rsel == 1 ? er[1] : rsel == 2 ? er[2] : er[3]; }
#pragma unroll
                  for (int e = 0; e < 32; ++e) {
                      const unsigned long long mk = __builtin_amdgcn_ballot_w64(myE == e);
                      const int rank = (int)__builtin_amdgcn_mbcnt_hi((unsigned)(mk >> 32), __builtin_amdgcn_mbcnt_lo((unsigned)mk, 0u));
                      const int base = __builtin_amdgcn_readlane(cnt, e);
                      if (myE == e) mypos = base + rank;
                      if (lane == e) cnt += (int)__builtin_popcountll(mk); } }
                LPOS[r0 * 4 + lane] = mypos;
                { const GAS float* scp = modl + (size_t)(bi * 6 + 4) * D; const GAS float* shp = modl + (size_t)(bi * 6 + 3) * D;
                  if (onepass) {
                  } else if (isx) {
                      int lane_o = lane; asm volatile("" : "+v"(lane_o));
#define lane lane_o
                      f32x4 gs[4], s0[4];
#pragma unroll
                      for (int j = 0; j < 4; ++j) { const f32x4 g4 = ((const GAS f32x4*)g)[lane * 4 + j], s1 = ((const GAS f32x4*)scp)[lane * 4 + j] + 1.0f; s0[j] = ((const GAS f32x4*)shp)[lane * 4 + j]; gs[j] = g4 * s1; }
                      v4u xr2[4][2], xr3[4][2];
#define N2_LD(BUF, r4) do { _Pragma("unroll") for (int q = 0; q < 4; ++q) _Pragma("unroll") for (int i = 0; i < 2; ++i) BUF[q][i] = __builtin_nontemporal_load((const GAS v4u*)(xrb + (size_t)((r4) + q) * D) + lane * 2 + i); } while (0)
#define N2_ROW(rowi, WSRC) do { const float rs = __int_as_float(__builtin_amdgcn_readlane(__float_as_int(rstd_l), (rowi))); v4u o; \
                      { const v4u w = WSRC[0]; const f32x4 va = (f32x4){bflo(w.x), bfhi(w.x), bflo(w.y), bfhi(w.y)}, vb = (f32x4){bflo(w.z), bfhi(w.z), bflo(w.w), bfhi(w.w)}; \
                        const f32x4 ha = va * (gs[0] * rs) + s0[0], hb = vb * (gs[1] * rs) + s0[1]; o.x = pk4_fp8(ha.x, ha.y, ha.z, ha.w); o.y = pk4_fp8(hb.x, hb.y, hb.z, hb.w); } \
                      { const v4u w = WSRC[1]; const f32x4 va = (f32x4){bflo(w.x), bfhi(w.x), bflo(w.y), bfhi(w.y)}, vb = (f32x4){bflo(w.z), bfhi(w.z), bflo(w.w), bfhi(w.w)}; \
                        const f32x4 ha = va * (gs[2] * rs) + s0[2], hb = vb * (gs[3] * rs) + s0[3]; o.z = pk4_fp8(ha.x, ha.y, ha.z, ha.w); o.w = pk4_fp8(hb.x, hb.y, hb.z, hb.w); } \
                      ((GAS v4u*)(HX8 + (size_t)(r0 + (rowi)) * D))[lane] = o; } while (0)
                      N2_LD(xr2, 0); N2_LD(xr3, 4);  N2_ROW(0, xr2[0]);  N2_ROW(1, xr2[1]);  N2_ROW(2, xr2[2]);   N2_ROW(3, xr2[3]);
                      N2_LD(xr2, 8);  N2_ROW(4, xr3[0]);  N2_ROW(5, xr3[1]);  N2_ROW(6, xr3[2]);   N2_ROW(7, xr3[3]);
                      N2_LD(xr3, 12); N2_ROW(8, xr2[0]);  N2_ROW(9, xr2[1]);  N2_ROW(10, xr2[2]);  N2_ROW(11, xr2[3]);
                      N2_ROW(12, xr3[0]); N2_ROW(13, xr3[1]); N2_ROW(14, xr3[2]); N2_ROW(15, xr3[3]);
#undef N2_ROW
#undef N2_LD
#undef lane
                  } else {
                  int lane_o = lane; asm volatile("" : "+v"(lane_o));
#define lane lane_o
                  f32x4 gg[4], s1[4], s0[4];
#pragma unroll
                  for (int j = 0; j < 4; ++j) { gg[j] = ((const GAS f32x4*)g)[lane + 64 * j]; s1[j] = ((const GAS f32x4*)scp)[lane + 64 * j] + 1.0f; s0[j] = ((const GAS f32x4*)shp)[lane + 64 * j]; gg[j] = gg[j] * s1[j]; }
                  for (int tt = 0; tt < 16; tt += 4) { f32x4 v[4][4];
#pragma unroll
                      for (int q = 0; q < 4; ++q) ld_row_any((const GAS void*)(xr + (size_t)(tt + q) * D), false, lane, v[q]);
#pragma unroll
                      for (int q = 0; q < 4; ++q) { const float rs = __int_as_float(__builtin_amdgcn_readlane(__float_as_int(rstd_l), tt + q)); GAS unsigned* dst = (GAS unsigned*)(HX8 + (size_t)(r0 + tt + q) * D);
#pragma unroll
                          for (int j = 0; j < 4; ++j) { const f32x4 hh = (v[q][j] * rs) * gg[j] + s0[j]; dst[lane + 64 * j] = pk4_fp8(hh.x, hh.y, hh.z, hh.w); } } }
#undef lane
                  }
                }
            }
            if (lane < 32) WVCNT[gw * 32 + lane] = cnt;
            __syncthreads();
        }
        SEAM(pb + 5);
        if (IN(pb + 6)) {
            PHASE_IDS();
            GAS unsigned char* ws = WSP();
            GAS int* ROWTOK = (GAS int*)(ws + WS_ROUTE + RT_ROWTOK);
            const GAS int* TOPI = (const GAS int*)(ws + WS_ROUTE + RT_TOPI); const GAS int* LPOS = (const GAS int*)(ws + WS_ROUTE + RT_LPOS); GAS int* SLOT = (GAS int*)(ws + WS_ROUTE + RT_SLOT); const GAS int* WVCNT = (const GAS int*)(ws + WS_ROUTE + RT_WVCNT);
            GAS int* META = (GAS int*)(ws + WS_META);
            LAS int* tmp = (LAS int*)(lds + MISC_OFF + MO_TMP);
            const int e = tid & 31, part = tid >> 5;
            { int tot = 0, pre = 0; const int lim = BX * 8;
              for (int idx = part * (NGW / 16); idx < (part + 1) * (NGW / 16); ++idx) { const int cval = WVCNT[idx * 32 + e]; tot += cval; if (idx < lim) pre += cval; }
              tmp[part * 32 + e] = tot; tmp[512 + part * 32 + e] = pre; }
            __syncthreads();
            if (tid < 32) { int tot = 0, pre = 0;
#pragma unroll
                for (int p = 0; p < 16; ++p) { tot += tmp[p * 32 + tid]; pre += tmp[512 + p * 32 + tid]; }
                tmp[1024 + tid] = tot; tmp[1056 + tid] = pre; }
            __syncthreads();
            if (tid < 33) { int ps = 0; for (int e2 = 0; e2 < tid; ++e2) ps += ((tmp[1024 + e2] + 255) >> 8) << 8; tmp[1088 + tid] = ps;
                if (BX == 0) META[l * 64 + tid] = ps; }
            __syncthreads();
            const int tpw = ntok / G;
            int basew = 0;
            if (lane < 32) { basew = tmp[1056 + lane]; for (int w2 = 0; w2 < wave; ++w2) basew += WVCNT[(BX * 8 + w2) * 32 + lane]; }
            const int xpw = TX / G, cpw = (ntok - TX) / G, nxt_ = xpw / 16;
            for (int ti_ = 0; ; ++ti_) { const int tile = n2_tile(wave, ti_, tpw / 16); if (tile < 0) break; const int r = (tile < nxt_) ? (BX * xpw + tile * 16) : (TX + BX * cpw + (tile - nxt_) * 16);
                const int ee = TOPI[r * 4 + lane], lp = LPOS[r * 4 + lane];
                const int bw = __builtin_amdgcn_ds_bpermute(ee << 2, basew); const int slot = tmp[1088 + ee] + bw + lp;
                SLOT[r * 4 + lane] = slot; ROWTOK[slot] = r + (lane >> 2); }
            if (BX < 32) { const int ee = BX; const int s0 = tmp[1088 + ee] + tmp[1024 + ee], s1 = tmp[1088 + ee + 1]; for (int sidx = s0 + tid; sidx < s1; sidx += 512) ROWTOK[sidx] = 0; }
            __syncthreads();
        }
        SEAM(pb + 6);
        if (IN(pb + 7) || IN(pb + 8)) {
            PHASE_IDS();
            LAS int* PS = (LAS int*)(lds + MISC_OFF + MO_PS); LAS unsigned char* tile_e = (LAS unsigned char*)(lds + MISC_OFF + MO_TILEE);
            { const GAS int* META = (const GAS int*)(WSP() + WS_META); if (tid < 33) PS[tid] = META[l * 64 + tid]; }
            __syncthreads();
            const int NT = PS[32] >> 8;
            for (int rt = tid; rt < NT; rt += 512) { int ee = 0; for (int e2 = 1; e2 < 32; ++e2) ee += (PS[e2] <= rt * 256) ? 1 : 0; tile_e[rt] = (unsigned char)ee; }
            __syncthreads();
            if (IN(pb + 7)) {
                GAS unsigned char* ws = WSP();
                Prob1 P{(const GAS int*)(ws + WS_ROUTE + RT_ROWTOK), ws + WS_HX, ws + WS_W1 + (size_t)l * 32 * 2048 * 1024, INP(I_B1) + (size_t)l * 32 * 2048, ws + WS_R1, tile_e, NT, BX, G};
                pg8::gemm_phase<Prob1>(lds, P, wave0);
            }
            SEAM(pb + 7);
            if (IN(pb + 8)) {
                GAS unsigned char* ws = WSP();
                Prob2 P{ws + WS_R1, ws + WS_W2 + (size_t)l * 32 * 1024 * 1024, INP(I_B2) + (size_t)l * 32 * 1024, ws + WS_R2, tile_e, NT, BX, G};
                pg8::gemm_phase<Prob2>(lds, P, wave0);
            }
        }
        SEAM(pb + 8);
    }

#if DBG_CHECK
    if (lo <= 19 && 19 < hi) {
        PHASE_IDS();
        GAS unsigned char* ws = WSP();
        const GAS bf16* HX = (const GAS bf16*)(ws + WS_HX); const GAS unsigned char* YB = ws + WS_R2;
        const GAS int* TOPI = (const GAS int*)(ws + WS_ROUTE + RT_TOPI); const GAS int* SLOT = (const GAS int*)(ws + WS_ROUTE + RT_SLOT); const GAS float* GATE = (const GAS float*)(ws + WS_ROUTE + RT_GATE);
        GAS unsigned* dbgw = (GAS unsigned*)(ws + WS_CTL) + 64;
        LAS float* hl = (LAS float*)lds; LAS float* al = hl + 1024; LAS float* yl = al + 1024; LAS float* red = yl + 1024;
        const int t = BX * 251 + 3;
        hl[tid] = bf1(HX[(size_t)t * D + tid]); hl[tid + 512] = bf1(HX[(size_t)t * D + tid + 512]); yl[tid] = 0.f; yl[tid + 512] = 0.f;
        __syncthreads();
#if DBG_CHECK == 1
        for (int k = 0; k < 4; ++k) {
            const int e = TOPI[t * 4 + k]; const float gt = GATE[t * 4 + k];
            const GAS float* w1e = INP(I_W1) + ((size_t)(32 + e)) * 1024 * 2048; const GAS float* b1e = INP(I_B1) + (size_t)(32 + e) * 2048;
            const GAS float* w2e = INP(I_W2) + ((size_t)(32 + e)) * 1024 * 1024; const GAS float* b2e = INP(I_B2) + (size_t)(32 + e) * 1024;
            float a0 = 0.f, a1 = 0.f, a2 = 0.f, a3 = 0.f;
            for (int kk = 0; kk < 1024; ++kk) { const float hv = hl[kk]; const GAS float* wr_ = w1e + (size_t)kk * 2048 + tid; a0 += hv * wr_[0]; a1 += hv * wr_[512]; a2 += hv * wr_[1024]; a3 += hv * wr_[1536]; }
            { float gl = fminf(a0 + b1e[tid], 7.f), ln = fminf(fmaxf(a2 + b1e[1024 + tid], -7.f), 7.f); al[tid] = gl * sigmoidf_(1.702f * gl) * (ln + 1.f);
              gl = fminf(a1 + b1e[512 + tid], 7.f); ln = fminf(fmaxf(a3 + b1e[1536 + tid], -7.f), 7.f); al[tid + 512] = gl * sigmoidf_(1.702f * gl) * (ln + 1.f); }
            __syncthreads();
            float c0 = 0.f, c1 = 0.f;
            for (int j = 0; j < 1024; ++j) { const float av = al[j]; c0 += av * w2e[(size_t)j * 1024 + tid]; c1 += av * w2e[(size_t)j * 1024 + tid + 512]; }
            yl[tid] += gt * (c0 + b2e[tid]); yl[tid + 512] += gt * (c1 + b2e[tid + 512]);
            __syncthreads();
        }
        float dsum = 0.f, rsum = 0.f;
#pragma unroll
        for (int q = 0; q < 2; ++q) { const int n = tid + 512 * q; float yp = 0.f;
            for (int k = 0; k < 4; ++k) yp += GATE[t * 4 + k] * bf1(YB[(size_t)SLOT[t * 4 + k] * D + n]);
            const float df = yp - yl[n]; dsum += df * df; rsum += yl[n] * yl[n]; }
        dsum = wave_sum(dsum); rsum = wave_sum(rsum);
        if (lane == 0) { red[wave] = dsum; red[8 + wave] = rsum; }
        __syncthreads();
        if (tid == 0) { float a = 0.f, b = 0.f; for (int w = 0; w < 8; ++w) { a += red[w]; b += red[8 + w]; }
            const float rel = sqrtf(a / fmaxf(b, 1e-20f)); atomicMax(dbgw, __builtin_bit_cast(unsigned, rel)); }
#else
        {
            const GAS float* rw = INP(I_RW) + (size_t)1 * 1024 * 32; const GAS float* rb = INP(I_RB) + 32;
            const int e = tid & 31, part = tid >> 5; float a = 0.f;
            for (int kk = part * 64; kk < part * 64 + 64; ++kk) a += hl[kk] * rw[kk * 32 + e];
            red[part * 32 + e] = a;
            __syncthreads();
            if (tid == 0) { float lg[32]; for (int e2 = 0; e2 < 32; ++e2) { float sacc = rb[e2]; for (int p = 0; p < 16; ++p) sacc += red[p * 32 + e2]; al[e2] = sacc; }
                int mism = 0;
                for (int k = 0; k < 4; ++k) { int best = 0; float bv = -3e38f; for (int e2 = 0; e2 < 32; ++e2) if (al[e2] > bv) { bv = al[e2]; best = e2; } al[best] = -3e38f;
                    bool found = false; for (int k2 = 0; k2 < 4; ++k2) found |= (TOPI[t * 4 + k2] == best); if (!found) mism++; }
                (void)lg; atomicAdd(dbgw, (unsigned)mism); }
        }
#endif
    }
    if (lo <= 20 && 20 < hi) {
        GAS float* out = OUTP(); const GAS unsigned* dbgw = (const GAS unsigned*)(WSP() + WS_CTL) + 64;
        const unsigned wv = *dbgw;
#if DBG_CHECK == 1
        const float metric = __builtin_bit_cast(float, wv);
#else
        const float metric = (float)wv / 1024.0f;
#endif
        const float V = sqrtf((float)TX * (float)D * 1000.0f * metric);
        for (size_t i = (size_t)BX * 512 + TIDX(wave0); i < (size_t)TX * D; i += (size_t)G * 512) out[i] = (i == 0) ? V : 0.f;
    }
#else
    if (IN(19)) {
            PHASE_IDS();
        GAS unsigned char* ws = WSP(); GAS float* out = OUTP();
        const GAS float* MOD = (const GAS float*)(ws + WS_MOD); const GAS unsigned char* YB = ws + WS_R2; const GAS bf16* XB = (const GAS bf16*)(ws + WS_XB);
        const GAS int* SLOT = (const GAS int*)(ws + WS_ROUTE + RT_SLOT); const GAS float* GATE = (const GAS float*)(ws + WS_ROUTE + RT_GATE);
        const GAS float* g = INP(I_FNG);
        for (int ra = gw; ra < TX; ra += 2 * NGW) { const int rb = (ra + NGW < TX) ? ra + NGW : ra; const int bia = ra >> 11, bib = rb >> 11;
            f32x4 va[4], vb[4];
            load_row2<!DBG_SKIP_MOE>(XB + (size_t)ra * D, true, XB + (size_t)rb * D, true, ra, rb, SLOT, GATE, YB, MOD + (size_t)((33 + bia) * 6 + 5) * D, MOD + (size_t)((33 + bib) * 6 + 5) * D, lane, va, vb);
            const float rsa = row_rstd(va), rsb = row_rstd(vb);
#pragma unroll
            for (int j = 0; j < 4; ++j) { const f32x4 gg = ((const GAS f32x4*)g)[lane + 64 * j]; __builtin_nontemporal_store(va[j] * rsa * gg, (GAS f32x4*)(out + (size_t)ra * D) + lane + 64 * j); if (rb != ra) __builtin_nontemporal_store(vb[j] * rsb * gg, (GAS f32x4*)(out + (size_t)rb * D) + lane + 64 * j); } }
    }
#endif
#undef IN
#undef SEAM
}

extern "C" void kernel_launch(void* const* d_in, const int* in_sizes, int n_in, void* d_out, int out_size, void* d_ws, size_t ws_size, hipStream_t stream) {
    static int grid = 0;
    if (grid == 0) {
        if (n_in != 30 || in_sizes[0] != TX * D || out_size != TX * D || ws_size < WS_END) { fprintf(stderr, "kernel_launch: unexpected problem (n_in %d, in0 %d, out %d, ws %zu); nothing launched\n", n_in, n_in > 0 ? in_sizes[0] : -1, out_size, ws_size); grid = -1; return; }
        int dev = 0, cus = 0;
        if (hipGetDevice(&dev) != hipSuccess || hipDeviceGetAttribute(&cus, hipDeviceAttributeMultiprocessorCount, dev) != hipSuccess) { grid = -1; return; }
        if (hipFuncSetAttribute((const void*)fwd, hipFuncAttributeMaxDynamicSharedMemorySize, LDS_BYTES) != hipSuccess) { fprintf(stderr, "kernel_launch: hipFuncSetAttribute failed\n"); grid = -1; return; }
        int per_cu = 0;
        if (hipOccupancyMaxActiveBlocksPerMultiprocessor(&per_cu, (const void*)fwd, 512, LDS_BYTES) != hipSuccess || per_cu < 1) fprintf(stderr, "kernel_launch: occupancy query says %d\n", per_cu);
        (void)hipGetLastError();
        grid = (cus >= 256) ? 256 : -1;
        if (grid < 0) { fprintf(stderr, "kernel_launch: needs 256 CUs, device has %d\n", cus); return; }
    }
    if (grid < 0) return;
    if (hipMemsetAsync((char*)d_ws + WS_CTL, 0, CTL_ZERO_BYTES, stream) != hipSuccess) return;
    Args a{};
    for (int i = 0; i < 30; ++i) a.in[i] = (const float*)d_in[i];
    a.out = (float*)d_out; a.ws = (unsigned char*)d_ws;
#if MK_LAUNCH_PER_PHASE
    for (int p = 0; p < NPHASE; ++p) { a.ph_lo = p; a.ph_hi = p + 1; hipLaunchKernelGGL(fwd, dim3(grid), dim3(512), LDS_BYTES, stream, a); }
#else
    a.ph_lo = 0; a.ph_hi = NPHASE;
    hipLaunchKernelGGL(fwd, dim3(grid), dim3(512), LDS_BYTES, stream, a);
#endif
}
```

```cpp
#include <hip/hip_runtime.h>
#include <cstdio>
#include <cstdint>

#define DBG_SKIP_MOE 0
#define DBG_CHECK 0
#ifndef MK_LAUNCH_PER_PHASE
#define MK_LAUNCH_PER_PHASE 0
#endif

#define GAS __attribute__((address_space(1)))
#define LAS __attribute__((address_space(3)))
typedef unsigned short bf16;
typedef unsigned v4u __attribute__((ext_vector_type(4)));
typedef unsigned v2u __attribute__((ext_vector_type(2)));
typedef float f32x4 __attribute__((ext_vector_type(4)));
typedef float f32x2 __attribute__((ext_vector_type(2)));
typedef short bf16x8 __attribute__((ext_vector_type(8)));

constexpr int D = 1024, NBATCH = 32, SEQ = 2048, CTXL = 256;
constexpr int TX = NBATCH * SEQ, TC = NBATCH * CTXL, TT = TX + TC;
constexpr int INW = 1792, NEXP = 32;
constexpr int OFF_K = 256, OFF_V = 384, OFF_CONV = 512, OFF_GMLP = 1024, OFF_POOL = 1536;
constexpr float EPS = 1e-6f;
constexpr int MAXROWS = 303104;
#ifndef DBG_CHECK
#define DBG_CHECK 0
#endif
constexpr int NPHASE = DBG_CHECK ? 21 : 20;

constexpr size_t MiB = 1ull << 20;
constexpr size_t WS_CTL = 0, CTL_ZERO_BYTES = 1 * MiB;
constexpr size_t WS_MOD = 1 * MiB;
constexpr size_t WS_ROPE = 3 * MiB;
constexpr size_t WS_META = 3 * MiB + 65536;
constexpr size_t WS_GWSB = 4 * MiB;
constexpr size_t WS_CPWT = 4 * MiB + 256 * 1024;
constexpr size_t WS_PWT = 4 * MiB + 512 * 1024;
constexpr size_t WS_WIN = 5 * MiB;
constexpr size_t WS_WOUT = 12 * MiB;
constexpr size_t WS_W1 = 16 * MiB;
constexpr size_t WS_W2 = 272 * MiB;
constexpr size_t WS_CTXR = 400 * MiB;
constexpr size_t WS_ROUTE = 432 * MiB;
constexpr size_t WS_HX = 440 * MiB;
constexpr size_t WS_R1 = 584 * MiB;
constexpr size_t WS_R2 = 1176 * MiB;
constexpr size_t WS_BMF = 1768 * MiB;
constexpr size_t WS_CVEC = WS_MOD + 1792 * 1024;
constexpr size_t WS_XB = 1784 * MiB;
constexpr size_t WS_END = 1912 * MiB;
constexpr size_t RT_TOPI = 0, RT_GATE = 1280 * 1024, RT_LPOS = 2560 * 1024, RT_SLOT = 3840 * 1024, RT_ROWTOK = 5 * MiB, RT_WVCNT = 6 * MiB + 512 * 1024;
constexpr int CW_BAR = 4096;

constexpr int RING_BYTES = 131072;
constexpr int MISC_OFF = RING_BYTES;
constexpr int LDS_BYTES = 147456;
constexpr int MO_BAR = 0;
constexpr int MO_PS = 256;
constexpr int MO_PT = 512;
constexpr int MO_TILEE = 1024;
constexpr int MO_ROWTAB = 12288;
constexpr int MO_TMP = 4096;

__device__ __forceinline__ int tidx_(int w0) { int t; asm volatile("v_mbcnt_lo_u32_b32 %0, -1, 0\n\tv_mbcnt_hi_u32_b32 %0, -1, %0" : "=v"(t)); return (w0 << 6) | t; }
#define TIDX(w0) tidx_(w0)
__device__ __forceinline__ int opq(int v) { asm volatile("" : "+s"(v)); return v; }
__device__ __forceinline__ int bidx_() { int b = blockIdx.x; asm volatile("" : "+s"(b)); return b; }
__device__ __forceinline__ int gdim_() { int g = gridDim.x; asm volatile("" : "+s"(g)); return g; }
typedef float f32x2c_ __attribute__((ext_vector_type(2)));
typedef __bf16 bf16x2c_ __attribute__((ext_vector_type(2)));
__device__ __forceinline__ unsigned pk2(float lo, float hi) { const f32x2c_ v = {lo, hi}; const bf16x2c_ b = __builtin_convertvector(v, bf16x2c_); return __builtin_bit_cast(unsigned, b); }
__device__ __forceinline__ unsigned f2bf(float f) { return pk2(f, 0.f) & 0xffffu; }
__device__ __forceinline__ float bflo(unsigned w) { return __builtin_bit_cast(float, w << 16); }
__device__ __forceinline__ float bfhi(unsigned w) { return __builtin_bit_cast(float, w & 0xffff0000u); }
__device__ __forceinline__ float bf1(bf16 h) { return __builtin_bit_cast(float, ((unsigned)h) << 16); }
__device__ __forceinline__ unsigned cvt_pk_bf16(float lo, float hi) { return pk2(lo, hi); }
template <int CTRL> __device__ __forceinline__ float dpp_f(float v) { return __int_as_float(__builtin_amdgcn_mov_dpp(__float_as_int(v), CTRL, 0xf, 0xf, true)); }
template <int CTRL> __device__ __forceinline__ int dpp_i(int v) { return __builtin_amdgcn_mov_dpp(v, CTRL, 0xf, 0xf, true); }
__device__ __forceinline__ float wave_sum(float v) {
    v += dpp_f<0xB1>(v); v += dpp_f<0x4E>(v); v += dpp_f<0x124>(v); v += dpp_f<0x128>(v);
    const float a = __int_as_float(__builtin_amdgcn_readlane(__float_as_int(v), 0)), b = __int_as_float(__builtin_amdgcn_readlane(__float_as_int(v), 16));
    const float c = __int_as_float(__builtin_amdgcn_readlane(__float_as_int(v), 32)), d = __int_as_float(__builtin_amdgcn_readlane(__float_as_int(v), 48));
    return (a + b) + (c + d);
}
__device__ __forceinline__ float xor32_sum(float v) { const auto rr = __builtin_amdgcn_permlane32_swap(__float_as_uint(v), __float_as_uint(v), false, false); return __uint_as_float(rr[0]) + __uint_as_float(rr[1]); }
__device__ __forceinline__ float xor32_max(float v) { const auto rr = __builtin_amdgcn_permlane32_swap(__float_as_uint(v), __float_as_uint(v), false, false); return fmaxf(__uint_as_float(rr[0]), __uint_as_float(rr[1])); }
__device__ __forceinline__ float xor16_sum(float v) { const auto rr = __builtin_amdgcn_permlane16_swap(__float_as_uint(v), __float_as_uint(v), false, false); return __uint_as_float(rr[0]) + __uint_as_float(rr[1]); }
__device__ __forceinline__ float xor32_other(float v, bool upper) { const auto rr = __builtin_amdgcn_permlane32_swap(__float_as_uint(v), __float_as_uint(v), false, false); return upper ? __uint_as_float(rr[0]) : __uint_as_float(rr[1]); }
__device__ __forceinline__ float sigmoidf_(float x) { return __builtin_amdgcn_rcpf(1.0f + __builtin_amdgcn_exp2f(-1.4426950408889634f * x)); }
#define LDS_WAIT() asm volatile("s_waitcnt lgkmcnt(0)" ::: "memory")
#define VM_WAIT() asm volatile("s_waitcnt vmcnt(0)" ::: "memory")

#define XB_TMO      128
#define XB_XCNT(j)  (256  + 64 * (j))
#define XB_XSUB(j)  (1280 + 64 * (j))
#define XB_XGEN(j)  (2304 + 64 * (j))
#define XB_TOP      3328
#define XB_TOPGEN   3392
#define XCD_BAR_WORDS 3456
#define XB_SPIN_CAP (1u << 18)
__device__ __forceinline__ unsigned xb_ld(GAS unsigned* p)              { return __hip_atomic_load(p, __ATOMIC_RELAXED, __HIP_MEMORY_SCOPE_AGENT); }
__device__ __forceinline__ unsigned xb_add(GAS unsigned* p, unsigned v) { return __hip_atomic_fetch_add(p, v, __ATOMIC_RELAXED, __HIP_MEMORY_SCOPE_AGENT); }
__device__ __forceinline__ unsigned xb_xcc_id() { return (unsigned)__builtin_amdgcn_s_getreg((3 << 11) | 20) & 0xFu; }
#define XB_SPIN(cond, bar) do { unsigned _sp = 0; while (cond) { __builtin_amdgcn_s_sleep(1); \
    if ((++_sp & 255u) == 0u) { if (xb_ld(&(bar)[XB_TMO])) break; if (_sp > XB_SPIN_CAP) { __hip_atomic_fetch_add(&(bar)[XB_TMO], 1u, __ATOMIC_RELAXED, __HIP_MEMORY_SCOPE_AGENT); break; } } } } while (0)
struct XcdBarrier { GAS unsigned* bar; unsigned x; volatile LAS unsigned* st; };
__device__ __forceinline__ XcdBarrier xcd_barrier_post(GAS unsigned* bar, volatile LAS unsigned* st, int w0) {
    XcdBarrier b; b.bar = bar; b.x = xb_xcc_id(); b.st = st;
    if (TIDX(w0) == 0) (void)xb_add(&bar[XB_XCNT(b.x)], 1u);
    return b;
}
__device__ __forceinline__ void xcd_barrier_complete(GAS unsigned* bar, unsigned x, unsigned& nloc, unsigned& nx) {
    const unsigned G = gridDim.x * gridDim.y * gridDim.z;
    unsigned sum, cnt, mine, sp = 0u;
    for (;;) {
        sum = 0u; cnt = 0u; mine = 0u;
#pragma unroll
        for (unsigned j = 0; j < 16; ++j) { const unsigned c = xb_ld(&bar[XB_XCNT(j)]); sum += c; cnt += (c > 0u) ? 1u : 0u; mine = (j == x) ? c : mine; }
        if (sum == G) break;
        __builtin_amdgcn_s_sleep(1);
        if ((++sp & 255u) == 0u) { if (xb_ld(&bar[XB_TMO])) break; if (sp > XB_SPIN_CAP) { __hip_atomic_fetch_add(&bar[XB_TMO], 1u, __ATOMIC_RELAXED, __HIP_MEMORY_SCOPE_AGENT); break; } }
    }
    nloc = mine > 0u ? mine : 1u; nx = cnt > 0u ? cnt : 1u;
}
__device__ __forceinline__ void xcd_barrier(const XcdBarrier& b0, int w0) {
    asm volatile("s_waitcnt vmcnt(0)" ::: "memory");
    __syncthreads();
    if (TIDX(w0) == 0) {
        XcdBarrier b; { unsigned long long bp = (unsigned long long)b0.bar; asm volatile("" : "+s"(bp)); b.bar = (GAS unsigned*)bp; b.x = (unsigned)opq((int)b0.x); b.st = b0.st; }
        GAS unsigned* bar = b.bar;
        __builtin_amdgcn_s_waitcnt(0);
        unsigned nloc = b.st[0], nx = b.st[1];
        if (nloc == 0u) { xcd_barrier_complete(bar, b.x, nloc, nx); b.st[0] = nloc; b.st[1] = nx; }
        const unsigned old = xb_add(&bar[XB_XSUB(b.x)], 1u);
        const unsigned gen = old / nloc;
        if (old + 1u == (gen + 1u) * nloc) {
            __builtin_amdgcn_fence(__ATOMIC_RELEASE, "agent");
            asm volatile("s_waitcnt vmcnt(0)" ::: "memory");
            const unsigned og = xb_add(&bar[XB_TOP], 1u);
            const unsigned tg = og / nx;
            if (og + 1u == (tg + 1u) * nx) xb_add(&bar[XB_TOPGEN], 1u);
            else XB_SPIN(xb_ld(&bar[XB_TOPGEN]) == tg, bar);
            __builtin_amdgcn_fence(__ATOMIC_ACQUIRE, "agent");
            xb_add(&bar[XB_XGEN(b.x)], 1u);
            asm volatile("s_waitcnt vmcnt(0)" ::: "memory");
        } else {
            XB_SPIN(xb_ld(&bar[XB_XGEN(b.x)]) == gen, bar);
            __builtin_amdgcn_fence(__ATOMIC_ACQUIRE, "agent");
            asm volatile("s_waitcnt vmcnt(0)" ::: "memory");
        }
    }
    __syncthreads();
}

namespace pg8 {
constexpr int BM = 256, BK = 64, HALF = 128, HTB = HALF * BK * 2, STAGE_BYTES = 8 * HTB;
__host__ __device__ __forceinline__ int lds_byte(int r, int c) { const int st = (r >> 4) * 2 + (c >> 5), rr = r & 15, cc = c & 31, ob = rr * 64 + cc * 2; return st * 1024 + (ob ^ (((ob >> 9) & 1) << 5)); }
__host__ __device__ __forceinline__ void stage_rc(int b, int& R, int& C) { const int st = b / 1024, sb = b % 1024, swz = sb ^ (((sb >> 9) & 1) << 5); R = (st >> 1) * 16 + swz / 64; C = (st & 1) * 32 + (swz % 64) / 2; }
__host__ __device__ __forceinline__ int perm32(int rho) { const int n = rho >> 4, i = rho & 15; return 8 * (i >> 2) + 4 * n + (i & 3); }
struct Unit { int pm, pn, e; };
typedef int v8i __attribute__((ext_vector_type(8)));
typedef int v4i_ __attribute__((ext_vector_type(4)));
__device__ __forceinline__ v8i cat8(bf16x8 a, bf16x8 b) { return __builtin_shufflevector(__builtin_bit_cast(v4i_, a), __builtin_bit_cast(v4i_, b), 0, 1, 2, 3, 4, 5, 6, 7); }

template <class P>
__device__ __forceinline__ void gemm_phase(LAS unsigned char* lds, const P& S, const int w0_) {
    const int w0 = opq(w0_);
    const int tid = TIDX(w0), wid = w0, lane = tid & 63, wr = wid >> 2, wc = wid & 3, fr = lane & 15, fq = lane >> 4;
    constexpr int K = P::K; constexpr bool F8 = P::FP8, GA = P::GATHER; constexpr int ROWB = F8 ? K : 2 * K, nt = ROWB / 128;
    unsigned voffA[2], voffB[2]; int R0 = 0, C0 = 0;
#pragma unroll
    for (int i = 0; i < 2; ++i) { int R, C; stage_rc(tid * 16 + i * 8192, R, C); const int Rb = P::PERM ? ((R & ~31) + perm32(R & 31)) : R; if (i == 0) { R0 = R; C0 = C; }
        voffA[i] = (unsigned)(R * ROWB + 2 * C); voffB[i] = (unsigned)(Rb * ROWB + 2 * C); }
    const unsigned kstep = 128u, hstep = (unsigned)(HALF * ROWB), hstepB = S.b_hstep();
    const __amdgpu_buffer_rsrc_t rsA = __builtin_amdgcn_make_buffer_rsrc((void*)S.a_base(), 0, 0x7fffffff, 0x00020000);
    const __amdgpu_buffer_rsrc_t rsB = __builtin_amdgcn_make_buffer_rsrc((void*)S.b_base(), 0, 0x7fffffff, 0x00020000);
    const unsigned ldsw = (unsigned)wid * 1024u;
    int sc8 = 0x7F7F7F7F; asm volatile("" : "+v"(sc8));
    const int aoff = lds_byte(wr * 64 + fr, fq * 8), boff = lds_byte(wc * 32 + fr, fq * 8);
    unsigned offA[4] = {0u, 0u, 0u, 0u}, offN[4] = {0u, 0u, 0u, 0u};
    LAS unsigned char* rowtab = lds + MISC_OFF + MO_ROWTAB;
#define PG8_SA(b, h) (((b) * 2 + (h)) * HTB)
#define PG8_SB(b, h) ((4 + (b) * 2 + (h)) * HTB)
#define PG8_STAGE(bufoff, rs, soff, voff) do { _Pragma("unroll") for (int _i = 0; _i < 2; ++_i) \
        __builtin_amdgcn_raw_ptr_buffer_load_lds((rs), (LAS unsigned*)(lds + (bufoff) + ldsw + _i * 8192), 16, (voff)[_i], (soff), 0, 0); } while (0)
#define PG8_STAGEA(bufoff, h, ubase, oo, kb) do { if constexpr (GA) { _Pragma("unroll") for (int _i = 0; _i < 2; ++_i) \
        __builtin_amdgcn_raw_ptr_buffer_load_lds(rsA, (LAS unsigned*)(lds + (bufoff) + ldsw + _i * 8192), 16, (oo)[2 * (h) + _i], (kb), 0, 0); } \
        else { PG8_STAGE(bufoff, rsA, (ubase) + (h) * hstep + (kb), voffA); } } while (0)
#define PG8_LDA(dst, b, h) do { _Pragma("unroll") for (int m = 0; m < 4; ++m) _Pragma("unroll") for (int k = 0; k < 2; ++k) dst[m][k] = *(const LAS bf16x8*)(lds + PG8_SA(b, h) + aoff + m * 2048 + k * 1024); } while (0)
#define PG8_LDB(dst, b, h) do { _Pragma("unroll") for (int n = 0; n < 2; ++n) _Pragma("unroll") for (int k = 0; k < 2; ++k) dst[n][k] = *(const LAS bf16x8*)(lds + PG8_SB(b, h) + boff + n * 2048 + k * 1024); } while (0)
#define PG8_MMA(ai, bj, At, Bt) do { __builtin_amdgcn_s_setprio(1); \
        if constexpr (!F8) { _Pragma("unroll") for (int m = 0; m < 4; ++m) _Pragma("unroll") for (int n = 0; n < 2; ++n) _Pragma("unroll") for (int k = 0; k < 2; ++k) \
            acc[ai][bj][m][n] = __builtin_amdgcn_mfma_f32_16x16x32_bf16(Bt[n][k], At[m][k], acc[ai][bj][m][n], 0, 0, 0); } \
        else { _Pragma("unroll") for (int m = 0; m < 4; ++m) _Pragma("unroll") for (int n = 0; n < 2; ++n) \
            asm volatile("v_mfma_scale_f32_16x16x128_f8f6f4 %0, %1, %2, %0, %3, %3 op_sel_hi:[0,0,0]" : "+v"(acc[ai][bj][m][n]) : "v"(cat8(Bt[n][0], Bt[n][1])), "v"(cat8(At[m][0], At[m][1])), "v"(sc8)); } \
        __builtin_amdgcn_s_setprio(0); } while (0)
#define PG8_MMAZ(ai, bj, At, Bt) do { __builtin_amdgcn_s_setprio(1); \
        _Pragma("unroll") for (int m = 0; m < 4; ++m) _Pragma("unroll") for (int n = 0; n < 2; ++n) \
            asm volatile("v_mfma_scale_f32_16x16x128_f8f6f4 %0, %1, %2, 0, %3, %3 op_sel_hi:[0,0,0]" : "+v"(acc[ai][bj][m][n]) : "v"(cat8(Bt[n][0], Bt[n][1])), "v"(cat8(At[m][0], At[m][1])), "v"(sc8)); \
        __builtin_amdgcn_s_setprio(0); } while (0)
#define PG8_WAIT_V(n) asm volatile("s_waitcnt vmcnt(" #n ")" ::: "memory")
#define PG8_WAIT_L(n) asm volatile("s_waitcnt lgkmcnt(" #n ")" ::: "memory")
#define PG8_BAR __builtin_amdgcn_s_barrier()
#define PG8_SCHED __builtin_amdgcn_sched_barrier(0)
    Unit cur, nxt; int ui = 0;
    if (!S.next(0, cur)) return;
    f32x4 acc[2][2][4][2];
#pragma unroll
    for (int a = 0; a < 2; ++a)
#pragma unroll
        for (int b = 0; b < 2; ++b)
#pragma unroll
            for (int m = 0; m < 4; ++m)
#pragma unroll
                for (int n = 0; n < 2; ++n) acc[a][b][m][n] = (f32x4){0.f, 0.f, 0.f, 0.f};
    bf16x8 At[4][2], B0[2][2], B1[2][2];
    typename P::Pre pre = {};
    unsigned cA = GA ? 0u : S.a_off(cur), cB = S.b_off(cur);
    if constexpr (GA) {
        const GAS int* rt = S.rowtab_g() + cur.pm * 256 + R0;
#pragma unroll
        for (int j = 0; j < 4; ++j) offA[j] = (unsigned)rt[64 * j] * (unsigned)ROWB + (unsigned)(2 * C0);
#pragma unroll
        for (int j = 0; j < 4; ++j) offN[j] = offA[j];
    }
    PG8_STAGE(PG8_SB(0, 0), rsB, cB, voffB); PG8_STAGE(PG8_SB(0, 1), rsB, cB + hstepB, voffB); PG8_STAGEA(PG8_SA(0, 0), 0, cA, offA, 0u); PG8_STAGEA(PG8_SA(0, 1), 1, cA, offA, 0u);
    if (wr == 1) PG8_BAR;
    PG8_WAIT_V(2); PG8_BAR;
    PG8_STAGE(PG8_SB(1, 0), rsB, cB + kstep, voffB); PG8_STAGEA(PG8_SA(1, 0), 0, cA, offA, kstep); PG8_STAGE(PG8_SB(1, 1), rsB, cB + hstepB + kstep, voffB);
    PG8_WAIT_V(6); PG8_BAR;
    for (;;) {
        const bool has_next = S.next(ui + 1, nxt);
        const unsigned nA = (has_next && !GA) ? S.a_off(nxt) : cA, nB = has_next ? S.b_off(nxt) : cB;
        if constexpr (GA) { if (has_next && wid < 4) {
            const __amdgpu_buffer_rsrc_t rsR = __builtin_amdgcn_make_buffer_rsrc((void*)S.rowtab_g(), 0, 0x7fffffff, 0x00020000);
            __builtin_amdgcn_raw_ptr_buffer_load_lds(rsR, (LAS unsigned*)(rowtab + ((ui + 1) & 1) * 1024 + wid * 256), 4, (unsigned)lane * 4u, (unsigned)(nxt.pm * 1024 + wid * 256), 0, 0); } }
        int t0 = 0;
        if constexpr (F8) {
            const unsigned k1 = kstep, k2 = 2u * kstep, k3 = 3u * kstep, b2 = cB + k2, b3 = b2 + kstep;
            PG8_LDB(B0, 0, 0); PG8_LDB(B1, 0, 1); PG8_SCHED; PG8_LDA(At, 0, 0); PG8_STAGEA(PG8_SA(1, 1), 1, cA, offA, k1);
            PG8_WAIT_V(8); PG8_WAIT_L(0); PG8_BAR; PG8_MMAZ(0, 0, At, B0); PG8_MMAZ(0, 1, At, B1); PG8_BAR; PG8_SCHED;
            PG8_LDA(At, 0, 1); PG8_STAGE(PG8_SB(0, 0), rsB, b2, voffB); PG8_STAGE(PG8_SB(0, 1), rsB, b2 + hstepB, voffB); PG8_STAGEA(PG8_SA(0, 0), 0, cA, offA, k2);
            PG8_WAIT_V(8); PG8_WAIT_L(0); PG8_BAR; PG8_MMAZ(1, 0, At, B0); PG8_MMAZ(1, 1, At, B1); PG8_BAR; PG8_SCHED;
            PG8_LDB(B0, 1, 0); PG8_LDB(B1, 1, 1); PG8_SCHED; PG8_LDA(At, 1, 0); PG8_STAGEA(PG8_SA(0, 1), 1, cA, offA, k2);
            PG8_WAIT_V(8); PG8_WAIT_L(0); PG8_BAR; PG8_MMA(0, 0, At, B0); PG8_MMA(0, 1, At, B1); PG8_BAR; PG8_SCHED;
            PG8_LDA(At, 1, 1); PG8_STAGE(PG8_SB(1, 0), rsB, b3, voffB); PG8_STAGE(PG8_SB(1, 1), rsB, b3 + hstepB, voffB); PG8_STAGEA(PG8_SA(1, 0), 0, cA, offA, k3);
            PG8_WAIT_V(8); PG8_WAIT_L(0); PG8_BAR; PG8_MMA(1, 0, At, B0); PG8_MMA(1, 1, At, B1); PG8_BAR; PG8_SCHED;
            t0 = 2;
        }
#pragma unroll 1
        for (int t = t0; t < nt; t += 2) {
            const bool last = (t == nt - 2);
            const unsigned k1 = (unsigned)(t + 1) * kstep, k2 = last ? 0u : (unsigned)(t + 2) * kstep, k3 = k2 + kstep;
            const unsigned uA2 = last ? nA : cA, b2 = (last ? nB : cB) + k2, b3 = b2 + kstep;
            if (last) S.prefetch(pre, cur, w0 & 3, lane & 15, lane >> 4);
            unsigned o2[4] = {0u, 0u, 0u, 0u};
            if constexpr (GA) {
                if (last && has_next) { const LAS int* tb = (const LAS int*)(rowtab + ((ui + 1) & 1) * 1024) + R0;
#pragma unroll
                    for (int j = 0; j < 4; ++j) offN[j] = (unsigned)tb[64 * j] * (unsigned)ROWB + (unsigned)(2 * C0); }
#pragma unroll
                for (int j = 0; j < 4; ++j) o2[j] = last ? offN[j] : offA[j];
            }
            PG8_LDB(B0, 0, 0); PG8_LDB(B1, 0, 1); PG8_SCHED; PG8_LDA(At, 0, 0); PG8_STAGEA(PG8_SA(1, 1), 1, cA, offA, k1);
            PG8_WAIT_V(8); PG8_WAIT_L(0); PG8_BAR; PG8_MMA(0, 0, At, B0); PG8_MMA(0, 1, At, B1); PG8_BAR; PG8_SCHED;
            PG8_LDA(At, 0, 1); PG8_STAGE(PG8_SB(0, 0), rsB, b2, voffB); PG8_STAGE(PG8_SB(0, 1), rsB, b2 + hstepB, voffB); PG8_STAGEA(PG8_SA(0, 0), 0, uA2, o2, k2);
            PG8_WAIT_V(8); PG8_WAIT_L(0); PG8_BAR; PG8_MMA(1, 0, At, B0); PG8_MMA(1, 1, At, B1); PG8_BAR; PG8_SCHED;
            PG8_LDB(B0, 1, 0); PG8_LDB(B1, 1, 1); PG8_SCHED; PG8_LDA(At, 1, 0); PG8_STAGEA(PG8_SA(0, 1), 1, uA2, o2, k2);
            PG8_WAIT_V(8); PG8_WAIT_L(0); PG8_BAR; PG8_MMA(0, 0, At, B0); PG8_MMA(0, 1, At, B1); PG8_BAR; PG8_SCHED;
            PG8_LDA(At, 1, 1); PG8_STAGE(PG8_SB(1, 0), rsB, b3, voffB); PG8_STAGE(PG8_SB(1, 1), rsB, b3 + hstepB, voffB); PG8_STAGEA(PG8_SA(1, 0), 0, uA2, o2, k3);
            PG8_WAIT_V(8); PG8_WAIT_L(0); PG8_BAR; PG8_MMA(1, 0, At, B0); PG8_MMA(1, 1, At, B1); PG8_BAR; PG8_SCHED;
        }
        if (wr == 0) PG8_BAR;
        if constexpr (F8) { asm volatile("s_nop 15\n\ts_nop 15" ::: "memory"); }
        { int te = TIDX(w0); asm volatile("" : "+v"(te)); const int lane2 = te & 63; S.epilogue(acc, cur, w0 >> 2, w0 & 3, lane2 & 15, lane2 >> 4, pre); }
        if (!has_next) break;
        if constexpr (!F8)
#pragma unroll
        for (int a = 0; a < 2; ++a)
#pragma unroll
            for (int b = 0; b < 2; ++b)
#pragma unroll
                for (int m = 0; m < 4; ++m)
#pragma unroll
                    for (int n = 0; n < 2; ++n) acc[a][b][m][n] = (f32x4){0.f, 0.f, 0.f, 0.f};
        cur = nxt; cA = nA; cB = nB; ++ui;
        if constexpr (GA) {
#pragma unroll
            for (int j = 0; j < 4; ++j) offA[j] = offN[j]; }
        if (wr == 1) PG8_BAR;
    }
    PG8_WAIT_V(0);
    PG8_BAR;
#undef PG8_SA
#undef PG8_SB
#undef PG8_STAGE
#undef PG8_STAGEA
#undef PG8_LDA
#undef PG8_LDB
#undef PG8_MMA
#undef PG8_MMAZ
#undef PG8_WAIT_V
#undef PG8_WAIT_L
#undef PG8_BAR
#undef PG8_SCHED
}
}

__device__ __forceinline__ int vunit(int i, int bx, int G) { const int c = (G % 8 == 0) ? (bx % 8) * (G / 8) + bx / 8 : bx; return i * G + c; }

constexpr float W8_SCALE = 64.0f, W8_INV = 1.0f / 64.0f;
struct ProbIn {
    static constexpr int K = 1024; static constexpr bool PERM = true, FP8 = true, GATHER = false;
    const GAS unsigned char* A; const GAS unsigned char* Bt; GAS bf16* O; int last; int bx, G; const GAS float* rope;
    __device__ __forceinline__ bool next(int i, pg8::Unit& u) const {
        const int v = vunit(i, bx, G); const int total = last ? 1824 : 2016; if (v >= total) return false;
        if (!last || v < 1792) { const int g = v / 56, w = v % 56; u.pm = g * 8 + (w & 7); u.pn = w >> 3; } else { u.pm = 256 + (v - 1792); u.pn = 1; }
        u.e = 0; return true; }
    __device__ __forceinline__ const GAS int* rowtab_g() const { return nullptr; }
    __device__ __forceinline__ const GAS void* a_base() const { return A; }
    __device__ __forceinline__ const GAS void* b_base() const { return Bt; }
    __device__ __forceinline__ unsigned a_off(const pg8::Unit& u) const { return (unsigned)u.pm * (256u * K); }
    __device__ __forceinline__ unsigned b_off(const pg8::Unit& u) const { return (unsigned)u.pn * (256u * K); }
    __device__ __forceinline__ unsigned b_hstep() const { return 128u * K; }
    struct Pre { int dummy; };
    __device__ __forceinline__ void prefetch(Pre&, const pg8::Unit&, int, int, int) const {}
    __device__ __forceinline__ void epilogue(const f32x4 (&acc)[2][2][4][2], const pg8::Unit& u, int wr, int wc, int fr, int fq, const Pre&) const {
        const int row0 = u.pm * 256 + wr * 64 + fr, col0 = u.pn * 256 + wc * 32 + 8 * fq;
        const bool ropet = (u.pm < 256) && (u.pn < 2);
#pragma unroll
        for (int ai = 0; ai < 2; ++ai)
#pragma unroll
            for (int m = 0; m < 4; ++m) { GAS bf16* rowp = O + (size_t)(row0 + ai * 128 + m * 16) * INW + col0;
#pragma unroll
                for (int bj = 0; bj < 2; ++bj) { f32x4 v0 = acc[ai][bj][m][0] * W8_INV, v1 = acc[ai][bj][m][1] * W8_INV;
                    if (ropet && (u.pn == 0 || bj == 0)) {
                        const int t = (row0 + ai * 128 + m * 16) & (SEQ - 1); const int pos = (wc & 1) ? (t & 63) : (t >> 6);
                        const GAS float* cp = rope + pos * 16 + 8 * (fq & 1);
                        const f32x4 c0 = *(const GAS f32x4*)cp, c1 = *(const GAS f32x4*)(cp + 4), s0 = *(const GAS f32x4*)(cp + 1024), s1 = *(const GAS f32x4*)(cp + 1028);
                        f32x4 p0, p1;
#pragma unroll
                        for (int j = 0; j < 4; ++j) { p0[j] = xor32_other(v0[j], fq >= 2); p1[j] = xor32_other(v1[j], fq >= 2); }
                        const float sg = (fq < 2) ? -1.0f : 1.0f;
                        v0 = v0 * c0 + (p0 * s0) * sg; v1 = v1 * c1 + (p1 * s1) * sg; }
                    v4u w; w.x = cvt_pk_bf16(v0[0], v0[1]); w.y = cvt_pk_bf16(v0[2], v0[3]); w.z = cvt_pk_bf16(v1[0], v1[1]); w.w = cvt_pk_bf16(v1[2], v1[3]);
                    *(GAS v4u*)(rowp + bj * 128) = w; } }
    }
};
struct ProbOut {
    static constexpr int K = 1024; static constexpr bool PERM = true, FP8 = false, GATHER = false;
    const GAS bf16* A; const GAS bf16* Bt; const GAS float* xin; const GAS float* cin; GAS bf16* xb; GAS float* cout; const GAS float* mod; int nrt; int srcbf; int bx, G;
    __device__ __forceinline__ bool next(int i, pg8::Unit& u) const {
        const int v = vunit(i, bx, G); if (v >= nrt * 4) return false;
        const int g = v >> 5, w = v & 31; u.pm = g * 8 + (w & 7); u.pn = w >> 3; u.e = 0; return true; }
    __device__ __forceinline__ const GAS int* rowtab_g() const { return nullptr; }
    __device__ __forceinline__ const GAS void* a_base() const { return A; }
    __device__ __forceinline__ const GAS void* b_base() const { return Bt; }
    __device__ __forceinline__ unsigned a_off(const pg8::Unit& u) const { return (unsigned)u.pm * (256u * K * 2); }
    __device__ __forceinline__ unsigned b_off(const pg8::Unit& u) const { return (unsigned)u.pn * (256u * K * 2); }
    __device__ __forceinline__ unsigned b_hstep() const { return 128u * K * 2; }
    struct Pre { f32x4 gv[2][2]; };
    __device__ __forceinline__ void prefetch(Pre& p, const pg8::Unit& u, int wc, int fr, int fq) const {
        const int rowt = u.pm * 256; const int bi = (rowt < TX) ? (rowt >> 11) : 32; const GAS float* g1 = mod + (size_t)(bi * 6 + 2) * D + u.pn * 256 + wc * 32 + 8 * fq;
#pragma unroll
        for (int bj = 0; bj < 2; ++bj)
#pragma unroll
            for (int n = 0; n < 2; ++n) p.gv[bj][n] = *(const GAS f32x4*)(g1 + bj * 128 + 4 * n); }
    __device__ __forceinline__ void epilogue(const f32x4 (&acc)[2][2][4][2], const pg8::Unit& u, int wr, int wc, int fr, int fq, const Pre& pre) const {
        const int rowt = u.pm * 256; const bool isx = rowt < TX;
        const int r0 = rowt + wr * 64 + fr, col0 = u.pn * 256 + wc * 32 + 8 * fq;
        if (isx) {
#pragma unroll
            for (int ai = 0; ai < 2; ++ai)
#pragma unroll
                for (int m = 0; m < 4; ++m) { const size_t ro = (size_t)(r0 + ai * 128 + m * 16) * D + col0;
#pragma unroll
                    for (int bj = 0; bj < 2; ++bj) { f32x4 x0, x1;
                        if (srcbf) { const v4u w = *(const GAS v4u*)(xb + ro + bj * 128); x0 = (f32x4){bflo(w.x), bfhi(w.x), bflo(w.y), bfhi(w.y)}; x1 = (f32x4){bflo(w.z), bfhi(w.z), bflo(w.w), bfhi(w.w)}; }
                        else { x0 = *(const GAS f32x4*)(xin + ro + bj * 128); x1 = *(const GAS f32x4*)(xin + ro + bj * 128 + 4); }
                        x0 += pre.gv[bj][0] * acc[ai][bj][m][0]; x1 += pre.gv[bj][1] * acc[ai][bj][m][1];
                        v4u o; o.x = cvt_pk_bf16(x0[0], x0[1]); o.y = cvt_pk_bf16(x0[2], x0[3]); o.z = cvt_pk_bf16(x1[0], x1[1]); o.w = cvt_pk_bf16(x1[2], x1[3]);
                        *(GAS v4u*)(xb + ro + bj * 128) = o; } }
        } else {
#pragma unroll
            for (int ai = 0; ai < 2; ++ai)
#pragma unroll
                for (int m = 0; m < 4; ++m) { const size_t ro = (size_t)(r0 - TX + ai * 128 + m * 16) * D + col0;
#pragma unroll
                    for (int bj = 0; bj < 2; ++bj)
#pragma unroll
                        for (int n = 0; n < 2; ++n) { const f32x4 xi = *(const GAS f32x4*)(cin + ro + bj * 128 + 4 * n);
                            *(GAS f32x4*)(cout + ro + bj * 128 + 4 * n) = xi + pre.gv[bj][n] * acc[ai][bj][m][n]; } }
        }
    }
};
__device__ __forceinline__ unsigned pk4_fp8(float a, float b, float c, float d) {
    a = fminf(fmaxf(a, -448.f), 448.f); b = fminf(fmaxf(b, -448.f), 448.f); c = fminf(fmaxf(c, -448.f), 448.f); d = fminf(fmaxf(d, -448.f), 448.f);
    int w = __builtin_amdgcn_cvt_pk_fp8_f32(a, b, 0, false); w = __builtin_amdgcn_cvt_pk_fp8_f32(c, d, w, true); return (unsigned)w;
}
__device__ __forceinline__ unsigned pk4_fp8_nc(float a, float b, float c, float d) { int w = __builtin_amdgcn_cvt_pk_fp8_f32(a, b, 0, false); w = __builtin_amdgcn_cvt_pk_fp8_f32(c, d, w, true); return (unsigned)w; }
struct Prob1 {
    static constexpr int K = 1024; static constexpr bool PERM = true, FP8 = true, GATHER = true;
    const GAS int* rowtok; const GAS unsigned char* A; const GAS unsigned char* W1; const GAS float* b1; GAS unsigned char* O; const LAS unsigned char* tile_e; int NT; int bx, G;
    __device__ __forceinline__ bool next(int i, pg8::Unit& u) const {
        const int v = vunit(i, bx, G); const int rt = (v >> 6) * 8 + (v & 7); if (rt >= NT) return false;
        u.pm = rt; u.pn = (v & 63) >> 3; u.e = __builtin_amdgcn_readfirstlane((int)tile_e[rt]); return true; }
    __device__ __forceinline__ const GAS void* a_base() const { return A; }
    __device__ __forceinline__ const GAS int* rowtab_g() const { return rowtok; }
    __device__ __forceinline__ const GAS void* b_base() const { return W1; }
    __device__ __forceinline__ unsigned a_off(const pg8::Unit& u) const { return (unsigned)u.pm * (256u * K); }
    __device__ __forceinline__ unsigned b_off(const pg8::Unit& u) const { return ((unsigned)u.e * 2048u + (unsigned)u.pn * 128u) * K; }
    __device__ __forceinline__ unsigned b_hstep() const { return 1024u * K; }
    struct Pre { f32x4 bg[2], bl[2]; };
    __device__ __forceinline__ void prefetch(Pre& p, const pg8::Unit& u, int wc, int fr, int fq) const {
        const GAS float* bb = b1 + (size_t)u.e * 2048 + u.pn * 128 + wc * 32 + 8 * fq;
#pragma unroll
        for (int n = 0; n < 2; ++n) { p.bg[n] = *(const GAS f32x4*)(bb + 4 * n); p.bl[n] = *(const GAS f32x4*)(bb + 1024 + 4 * n); } }
    __device__ __forceinline__ void epilogue(const f32x4 (&acc)[2][2][4][2], const pg8::Unit& u, int wr, int wc, int fr, int fq, const Pre& pre) const {
        const int row0 = u.pm * 256 + wr * 64 + fr, j0 = u.pn * 128 + wc * 32 + 8 * fq;
        const f32x4 (&bg)[2] = pre.bg; const f32x4 (&bl)[2] = pre.bl;
#pragma unroll
        for (int ai = 0; ai < 2; ++ai)
#pragma unroll
            for (int m = 0; m < 4; ++m) { GAS unsigned char* rowp = O + (size_t)(row0 + ai * 128 + m * 16) * 1024 + j0;
                f32x4 rr[2];
#pragma unroll
                for (int n = 0; n < 2; ++n) {
                    f32x4 gl = acc[ai][0][m][n] * W8_INV + bg[n], ln = acc[ai][1][m][n] * W8_INV + bl[n];
                    gl = __builtin_elementwise_min(gl, (f32x4){7.f, 7.f, 7.f, 7.f});
                    ln = __builtin_elementwise_min(__builtin_elementwise_max(ln, (f32x4){-7.f, -7.f, -7.f, -7.f}), (f32x4){7.f, 7.f, 7.f, 7.f});
                    const f32x4 tt = gl * (-1.702f * 1.4426950408889634f); f32x4 den;
                    den.x = __builtin_amdgcn_exp2f(tt.x); den.y = __builtin_amdgcn_exp2f(tt.y); den.z = __builtin_amdgcn_exp2f(tt.z); den.w = __builtin_amdgcn_exp2f(tt.w);
                    den = den + 1.0f; f32x4 sg;
                    sg.x = __builtin_amdgcn_rcpf(den.x); sg.y = __builtin_amdgcn_rcpf(den.y); sg.z = __builtin_amdgcn_rcpf(den.z); sg.w = __builtin_amdgcn_rcpf(den.w);
                    rr[n] = (gl * sg) * (ln + 1.0f); }
                const float r[8] = {rr[0].x, rr[0].y, rr[0].z, rr[0].w, rr[1].x, rr[1].y, rr[1].z, rr[1].w};
                v2u w; w.x = pk4_fp8_nc(r[0], r[1], r[2], r[3]); w.y = pk4_fp8_nc(r[4], r[5], r[6], r[7]);
                *(GAS v2u*)rowp = w; }
    }
};
struct Prob2 {
    static constexpr int K = 1024; static constexpr bool PERM = true, FP8 = true, GATHER = false;
    const GAS unsigned char* A; const GAS unsigned char* W2; const GAS float* b2; GAS unsigned char* O; const LAS unsigned char* tile_e; int NT; int bx, G;
    __device__ __forceinline__ bool next(int i, pg8::Unit& u) const {
        const int v = vunit(i, bx, G); const int rt = (v >> 5) * 8 + (v & 7); if (rt >= NT) return false;
        u.pm = rt; u.pn = (v & 31) >> 3; u.e = __builtin_amdgcn_readfirstlane((int)tile_e[rt]); return true; }
    __device__ __forceinline__ const GAS int* rowtab_g() const { return nullptr; }
    __device__ __forceinline__ const GAS void* a_base() const { return A; }
    __device__ __forceinline__ const GAS void* b_base() const { return W2; }
    __device__ __forceinline__ unsigned a_off(const pg8::Unit& u) const { return (unsigned)u.pm * (256u * K); }
    __device__ __forceinline__ unsigned b_off(const pg8::Unit& u) const { return ((unsigned)u.e * 1024u + (unsigned)u.pn * 256u) * K; }
    __device__ __forceinline__ unsigned b_hstep() const { return 128u * K; }
    struct Pre { f32x4 bv[2][2]; };
    __device__ __forceinline__ void prefetch(Pre& p, const pg8::Unit& u, int wc, int fr, int fq) const {
        const GAS float* bb = b2 + (size_t)u.e * 1024 + u.pn * 256 + wc * 32 + 8 * fq;
#pragma unroll
        for (int bj = 0; bj < 2; ++bj)
#pragma unroll
            for (int n = 0; n < 2; ++n) p.bv[bj][n] = *(const GAS f32x4*)(bb + bj * 128 + 4 * n); }
    __device__ __forceinline__ void epilogue(const f32x4 (&acc)[2][2][4][2], const pg8::Unit& u, int wr, int wc, int fr, int fq, const Pre& pre) const {
        const int row0 = u.pm * 256 + wr * 64 + fr, col0 = u.pn * 256 + wc * 32 + 8 * fq;
        const f32x4 (&bv)[2][2] = pre.bv;
#pragma unroll
        for (int ai = 0; ai < 2; ++ai)
#pragma unroll
            for (int m = 0; m < 4; ++m) { GAS unsigned char* rowp = O + (size_t)(row0 + ai * 128 + m * 16) * 1024 + col0;
#pragma unroll
                for (int bj = 0; bj < 2; ++bj) { const f32x4 v0 = acc[ai][bj][m][0] * W8_INV + bv[bj][0], v1 = acc[ai][bj][m][1] * W8_INV + bv[bj][1];
                    v2u w; w.x = pk4_fp8(v0[0], v0[1], v0[2], v0[3]); w.y = pk4_fp8(v1[0], v1[1], v1[2], v1[3]);
                    *(GAS v2u*)(rowp + bj * 128) = w; } }
    }
};

__device__ __forceinline__ int n2_tile(int wave, int i, int ntile) {
    if (ntile != 18) { const int t = wave + 8 * i; return t < ntile ? t : -1; }
    if (wave < 2) return i == 0 ? 16 + wave : (i == 1 ? wave : -1);
    if (i == 0) return wave;
    if (i == 1) return wave + 6;
    if (i == 2 && wave < 4) return wave + 12;
    return -1;
}
struct Args { const float* in[30]; float* out; unsigned char* ws; int ph_lo, ph_hi; };
enum { I_X = 0, I_C, I_CTX, I_CCTX, I_ADAW, I_ADAB, I_N1G, I_N2G, I_WIN, I_SINK, I_DWW, I_DWB, I_CLNG, I_CLNB, I_CPW, I_GLNG, I_GLNB, I_GWS, I_GBS, I_POOLW, I_PSCALE, I_GNG, I_WOUT, I_RW, I_RB, I_W1, I_B1, I_W2, I_B2, I_FNG };

__device__ __forceinline__ void p0_transpose_item(const GAS float* W, int K, int N, GAS bf16* WT, LAS float* scr, int item, int lane) {
    const int nblk = N / 32, kb = item / nblk, nb = item % nblk, k0 = 64 * kb, n0 = 32 * nb;
#pragma unroll
    for (int i = 0; i < 32; ++i) { const int kk = 2 * i + (lane >> 5); scr[kk * 33 + (lane & 31)] = W[(size_t)(k0 + kk) * N + n0 + (lane & 31)]; }
    LDS_WAIT(); asm volatile("" ::: "memory");
    const int c = lane & 7;
#pragma unroll
    for (int j = 0; j < 4; ++j) { const int n = (lane >> 3) + 8 * j; const LAS float* s = scr + (8 * c) * 33 + n;
        v4u o; o.x = pk2(s[0 * 33], s[1 * 33]); o.y = pk2(s[2 * 33], s[3 * 33]); o.z = pk2(s[4 * 33], s[5 * 33]); o.w = pk2(s[6 * 33], s[7 * 33]);
        *(GAS v4u*)(WT + (size_t)(n0 + n) * K + k0 + 8 * c) = o; }
    LDS_WAIT(); asm volatile("" ::: "memory");
}

struct P0Item { const GAS float* src; GAS unsigned char* dst; int N; };
__device__ __forceinline__ P0Item p0_f8_decode(int r, const GAS float* w1, const GAS float* w2, const GAS float* win, GAS unsigned char* W1_T, GAS unsigned char* W2_T, GAS unsigned char* WIN_T, int lane) {
    const int kg = lane >> 3, n4 = (lane & 7) * 4; P0Item it;
    if (r < 32768) { const int mi = r >> 9, li = r & 511, kb = li >> 6, nb = li & 63; it.N = 2048;
        it.src = w1 + (size_t)mi * 1024 * 2048 + (size_t)(128 * kb + 16 * kg) * 2048 + 32 * nb + n4; it.dst = W1_T + (size_t)mi * 2048 * 1024 + (size_t)(32 * nb + n4) * 1024 + 128 * kb + 16 * kg; }
    else if (r < 49152) { const int r2 = r - 32768, mi = r2 >> 8, li = r2 & 255, kb = li >> 5, nb = li & 31; it.N = 1024;
        it.src = w2 + (size_t)mi * 1024 * 1024 + (size_t)(128 * kb + 16 * kg) * 1024 + 32 * nb + n4; it.dst = W2_T + (size_t)mi * 1024 * 1024 + (size_t)(32 * nb + n4) * 1024 + 128 * kb + 16 * kg; }
    else { const int r2 = r - 49152, mi = r2 / 448, li = r2 % 448, kb = li / 56, nb = li % 56; it.N = 1792;
        it.src = win + (size_t)mi * 1024 * 1792 + (size_t)(128 * kb + 16 * kg) * 1792 + 32 * nb + n4; it.dst = WIN_T + (size_t)mi * 1792 * 1024 + (size_t)(32 * nb + n4) * 1024 + 128 * kb + 16 * kg; }
    return it;
}
__device__ __forceinline__ void p0_f8_load(const P0Item& it, f32x4 (&ld)[16]) {
#pragma unroll
    for (int i = 0; i < 16; ++i) ld[i] = __builtin_nontemporal_load((const GAS f32x4*)(it.src + (size_t)i * it.N));
}
__device__ __forceinline__ void p0_f8_store(GAS unsigned char* dst, const f32x4 (&ld)[16]) {
    unsigned T[4][4];
#pragma unroll
    for (int q = 0; q < 4; ++q) {
        unsigned Dw[4];
#pragma unroll
        for (int r = 0; r < 4; ++r) { const f32x4 v = ld[4 * q + r] * W8_SCALE; Dw[r] = pk4_fp8_nc(v.x, v.y, v.z, v.w); }
        const unsigned X0 = __builtin_amdgcn_perm(Dw[1], Dw[0], 0x05010400u), X1 = __builtin_amdgcn_perm(Dw[1], Dw[0], 0x07030602u);
        const unsigned Y0 = __builtin_amdgcn_perm(Dw[3], Dw[2], 0x05010400u), Y1 = __builtin_amdgcn_perm(Dw[3], Dw[2], 0x07030602u);
        T[0][q] = __builtin_amdgcn_perm(Y0, X0, 0x05040100u); T[1][q] = __builtin_amdgcn_perm(Y0, X0, 0x07060302u);
        T[2][q] = __builtin_amdgcn_perm(Y1, X1, 0x05040100u); T[3][q] = __builtin_amdgcn_perm(Y1, X1, 0x07060302u);
    }
#pragma unroll
    for (int j = 0; j < 4; ++j) { v4u o; o.x = T[j][0]; o.y = T[j][1]; o.z = T[j][2]; o.w = T[j][3]; *(GAS v4u*)(dst + (size_t)j * 1024) = o; }
}

template <bool COMB>
__device__ __forceinline__ void load_row(const GAS float* src, int r, const GAS int* slot, const GAS float* gate, const GAS bf16* Y, const GAS float* g2, int lane, f32x4 (&v)[4]) {
#pragma unroll
    for (int j = 0; j < 4; ++j) v[j] = COMB ? ((const GAS f32x4*)src)[lane + 64 * j] : __builtin_nontemporal_load((const GAS f32x4*)src + lane + 64 * j);
    if (COMB) {
        f32x4 dl[4];
#pragma unroll
        for (int j = 0; j < 4; ++j) dl[j] = (f32x4){0.f, 0.f, 0.f, 0.f};
#pragma unroll
        for (int k = 0; k < 4; ++k) { const int s = slot[r * 4 + k]; const float gt = gate[r * 4 + k]; const GAS v2u* yp = (const GAS v2u*)(Y + (size_t)s * 1024);
#pragma unroll
            for (int j = 0; j < 4; ++j) { const v2u w = yp[lane + 64 * j]; dl[j] += gt * (f32x4){bflo(w.x), bfhi(w.x), bflo(w.y), bfhi(w.y)}; } }
#pragma unroll
        for (int j = 0; j < 4; ++j) v[j] += ((const GAS f32x4*)g2)[lane + 64 * j] * dl[j];
    }
}
typedef float f32x2_ __attribute__((ext_vector_type(2)));
__device__ __forceinline__ f32x4 unpk4_fp8(unsigned w) { const f32x2_ lo = __builtin_amdgcn_cvt_pk_f32_fp8((int)w, false), hi = __builtin_amdgcn_cvt_pk_f32_fp8((int)w, true); return (f32x4){lo.x, lo.y, hi.x, hi.y}; }
__device__ __forceinline__ void ld_row_any(const GAS void* src, bool bf, int lane, f32x4 (&v)[4]) {
    if (bf) {
#pragma unroll
        for (int j = 0; j < 4; ++j) { const v2u w = ((const GAS v2u*)src)[lane + 64 * j]; v[j] = (f32x4){bflo(w.x), bfhi(w.x), bflo(w.y), bfhi(w.y)}; }
    } else {
#pragma unroll
        for (int j = 0; j < 4; ++j) v[j] = ((const GAS f32x4*)src)[lane + 64 * j];
    }
}
__device__ __forceinline__ void st_row_bf16(GAS bf16* dst, int lane, const f32x4 (&v)[4]) {
#pragma unroll
    for (int j = 0; j < 4; ++j) { v2u w; w.x = pk2(v[j].x, v[j].y); w.y = pk2(v[j].z, v[j].w); ((GAS v2u*)dst)[lane + 64 * j] = w; }
}
__device__ __forceinline__ void ld_row_any_nt(const GAS void* src, bool bf, int lane, f32x4 (&v)[4]) {
    if (bf) {
#pragma unroll
        for (int j = 0; j < 4; ++j) { const v2u w = __builtin_nontemporal_load((const GAS v2u*)src + lane + 64 * j); v[j] = (f32x4){bflo(w.x), bfhi(w.x), bflo(w.y), bfhi(w.y)}; }
    } else {
#pragma unroll
        for (int j = 0; j < 4; ++j) v[j] = __builtin_nontemporal_load((const GAS f32x4*)src + lane + 64 * j);
    }
}
template <bool COMB>
__device__ __forceinline__ void load_row2(const GAS void* srca, bool bfa, const GAS void* srcb, bool bfb, int ra, int rb, const GAS int* slot, const GAS float* gate, const GAS unsigned char* Y, const GAS float* g2a, const GAS float* g2b, int lane, f32x4 (&va)[4], f32x4 (&vb)[4]) {
    ld_row_any_nt(srca, bfa, lane, va); ld_row_any_nt(srcb, bfb, lane, vb);
    if (COMB) {
        int sa[4], sb[4]; float ga[4], gb[4];
#pragma unroll
        for (int k = 0; k < 4; ++k) { sa[k] = slot[ra * 4 + k]; sb[k] = slot[rb * 4 + k]; ga[k] = gate[ra * 4 + k]; gb[k] = gate[rb * 4 + k]; }
        unsigned ya[4][4], yb[4][4];
#pragma unroll
        for (int k = 0; k < 4; ++k)
#pragma unroll
            for (int j = 0; j < 4; ++j) { ya[k][j] = ((const GAS unsigned*)(Y + (size_t)sa[k] * 1024))[lane + 64 * j]; yb[k][j] = ((const GAS unsigned*)(Y + (size_t)sb[k] * 1024))[lane + 64 * j]; }
#pragma unroll
        for (int j = 0; j < 4; ++j) { f32x4 da = (f32x4){0.f, 0.f, 0.f, 0.f}, db = (f32x4){0.f, 0.f, 0.f, 0.f};
#pragma unroll
            for (int k = 0; k < 4; ++k) { da += ga[k] * unpk4_fp8(ya[k][j]); db += gb[k] * unpk4_fp8(yb[k][j]); }
            va[j] += ((const GAS f32x4*)g2a)[lane + 64 * j] * da; vb[j] += ((const GAS f32x4*)g2b)[lane + 64 * j] * db; }
    }
}
__device__ __forceinline__ float row_rstd(const f32x4 (&v)[4]) {
    float ss = 0.f;
#pragma unroll
    for (int j = 0; j < 4; ++j) ss += (v[j].x * v[j].x + v[j].y * v[j].y) + (v[j].z * v[j].z + v[j].w * v[j].w);
    ss = wave_sum(ss);
    return __builtin_amdgcn_rsqf(ss * (1.0f / D) + EPS);
}
__device__ __forceinline__ void mod_store_fp8(const f32x4 (&v)[4], float rstd, const GAS float* g, const GAS float* sc, const GAS float* sh, GAS unsigned char* orow, int lane) {
#pragma unroll
    for (int j = 0; j < 4; ++j) { const f32x4 gg = ((const GAS f32x4*)g)[lane + 64 * j], s1 = ((const GAS f32x4*)sc)[lane + 64 * j], s0 = ((const GAS f32x4*)sh)[lane + 64 * j];
        const f32x4 hh = (v[j] * rstd * gg) * (s1 + 1.0f) + s0;
        ((GAS unsigned*)orow)[lane + 64 * j] = pk4_fp8(hh.x, hh.y, hh.z, hh.w); }
}
__device__ __forceinline__ void mod_store_bf16(const f32x4 (&v)[4], float rstd, const GAS float* g, const GAS float* sc, const GAS float* sh, GAS bf16* orow, int lane, f32x4 (&h)[4]) {
#pragma unroll
    for (int j = 0; j < 4; ++j) { const f32x4 gg = ((const GAS f32x4*)g)[lane + 64 * j], s1 = ((const GAS f32x4*)sc)[lane + 64 * j], s0 = ((const GAS f32x4*)sh)[lane + 64 * j];
        h[j] = (v[j] * rstd * gg) * (s1 + 1.0f) + s0;
        v2u w; w.x = pk2(h[j].x, h[j].y); w.y = pk2(h[j].z, h[j].w); ((GAS v2u*)orow)[lane + 64 * j] = w; }
}

typedef float f32x16 __attribute__((ext_vector_type(16)));
#define MFMA32(a, b, c) __builtin_amdgcn_mfma_f32_32x32x16_bf16((a), (b), (c), 0, 0, 0)
constexpr int AT_KST = 144, AT_VST = 264, AT_KB = 128 * AT_KST, AT_VB = 64 * AT_VST, AT_BUF = AT_KB + AT_VB, AT_SS = 3 * AT_BUF;
#define AT_TILE(NB, MASK) do { \
    f32x16 S[NB]; \
    _Pragma("unroll") for (int mt = 0; mt < NB; ++mt) _Pragma("unroll") for (int r = 0; r < 16; ++r) S[mt][r] = 0.f; \
    { bf16x8 kf[2][NB]; \
      _Pragma("unroll") for (int mt = 0; mt < NB; ++mt) kf[0][mt] = *(const LAS bf16x8*)(lds + kofs[mt] + kl); \
      _Pragma("unroll") for (int s4 = 0; s4 < 4; ++s4) { \
          if (s4 < 3) { _Pragma("unroll") for (int mt = 0; mt < NB; ++mt) kf[(s4 + 1) & 1][mt] = *(const LAS bf16x8*)(lds + kofs[mt] + kl + 32 * (s4 + 1)); } \
          _Pragma("unroll") for (int mt = 0; mt < NB; ++mt) S[mt] = MFMA32(kf[s4 & 1][mt], qf[s4], S[mt]); } \
      __builtin_amdgcn_sched_group_barrier(0x100, 2 * NB, 0); \
      _Pragma("unroll") for (int i = 0; i < 2 * NB; ++i) { __builtin_amdgcn_sched_group_barrier(0x008, 1, 0); __builtin_amdgcn_sched_group_barrier(0x100, 1, 0); } \
      __builtin_amdgcn_sched_group_barrier(0x008, 2 * NB, 0); } \
    MASK \
    float mx; \
    { f32x16 m4 = S[0]; _Pragma("unroll") for (int mt = 1; mt < NB; ++mt) m4 = __builtin_elementwise_max(m4, S[mt]); \
      float a0 = fmaxf(fmaxf(m4[0], m4[1]), m4[2]), a1 = fmaxf(fmaxf(m4[3], m4[4]), m4[5]), a2 = fmaxf(fmaxf(m4[6], m4[7]), m4[8]), a3 = fmaxf(fmaxf(m4[9], m4[10]), m4[11]), a4 = fmaxf(fmaxf(m4[12], m4[13]), m4[14]); \
      mx = fmaxf(fmaxf(fmaxf(a0, a1), fmaxf(a2, a3)), fmaxf(a4, m4[15])); } \
    mx = xor32_max(mx); \
    const float msn = fmaxf(ms, mx * C1), corr = __builtin_amdgcn_exp2f(ms - msn); \
    ms = msn; lsum *= corr; \
    O0 = O0 * corr; O1 = O1 * corr; \
    f32x16 psv; \
    _Pragma("unroll") for (int mt = 0; mt < NB; ++mt) { const f32x16 tsc = S[mt] * C1 - ms; \
        _Pragma("unroll") for (int r = 0; r < 16; ++r) S[mt][r] = __builtin_amdgcn_exp2f(tsc[r]); \
        psv = (mt == 0) ? S[0] : psv + S[mt]; } \
    { float ps = ((psv[0] + psv[1]) + (psv[2] + psv[3])) + ((psv[4] + psv[5]) + (psv[6] + psv[7])) + (((psv[8] + psv[9]) + (psv[10] + psv[11])) + ((psv[12] + psv[13]) + (psv[14] + psv[15]))); \
      lsum += ps; } \
    _Pragma("unroll") for (int mt = 0; mt < NB; ++mt) _Pragma("unroll") for (int sp = 0; sp < 2; ++sp) { \
        v4u pw; pw.x = cvt_pk_bf16(S[mt][8 * sp + 0], S[mt][8 * sp + 1]); pw.y = cvt_pk_bf16(S[mt][8 * sp + 2], S[mt][8 * sp + 3]); \
        pw.z = cvt_pk_bf16(S[mt][8 * sp + 4], S[mt][8 * sp + 5]); pw.w = cvt_pk_bf16(S[mt][8 * sp + 6], S[mt][8 * sp + 7]); \
        const bf16x8 pb = __builtin_bit_cast(bf16x8, pw); \
        const LAS unsigned char* vp = lds + vofs[mt] + vl + 32 * sp; \
        { const v2u a0 = *(const LAS v2u*)vp, a1 = *(const LAS v2u*)(vp + 16); v4u vw; vw.x = a0.x; vw.y = a0.y; vw.z = a1.x; vw.w = a1.y; O0 = MFMA32(__builtin_bit_cast(bf16x8, vw), pb, O0); } \
        { const v2u a0 = *(const LAS v2u*)(vp + 32 * AT_VST), a1 = *(const LAS v2u*)(vp + 32 * AT_VST + 16); v4u vw; vw.x = a0.x; vw.y = a0.y; vw.z = a1.x; vw.w = a1.y; O1 = MFMA32(__builtin_bit_cast(bf16x8, vw), pb, O1); } } \
    } while (0)
__device__ __forceinline__ void attn_mfma(const GAS bf16* PX, GAS bf16* MIX, const GAS float* sink, const GAS float* gng, LAS unsigned char* lds, int nunits, const int w0_) {
    const int w0 = opq(w0_);
    const int tid = TIDX(w0), lane = tid & 63, wave = w0;
    const int g = wave >> 2, qi0 = (wave & 3) * 32, ql = lane & 31, hi = lane >> 5;
    const float LOG2E = 1.4426950408889634f, C1 = 0.125f * LOG2E;
    LAS float* ssT = (LAS float*)(lds + AT_SS);
    const int kl = ql * AT_KST + 16 * hi, vl = ql * AT_VST + 8 * hi;
    const int bx_ = bidx_(), gd_ = gdim_();
    for (int uu_ = bx_; uu_ < nunits; uu_ += gd_) { int u = uu_;
        if (uu_ < 512 && gd_ == 256) { const int k_ = uu_ >> 8, c_ = uu_ & 255, xcd_ = c_ & 7, j_ = c_ >> 3; u = ((k_ * 16 + xcd_ * 2 + (j_ >> 4)) << 4) | (j_ & 15); }
        const bool isx = u < 512;
        const int b = isx ? (u >> 4) : ((u - 512) >> 1);
        const int n = u & 15;
        const int rowbase = isx ? (b * SEQ + n * 128) : (TX + b * CTXL + (u & 1) * 128);
        const int qrow = rowbase + qi0 + ql, qi = qi0 + ql;
        const int nfull = isx ? 3 : 2;
        const bool validA = n > 0, validB = n < 15;
        f32x16 Oa[2], O0, O1;
#pragma unroll 1
        for (int kvh = 0; kvh < 2; ++kvh) {
            const int h = kvh * 2 + g;
            bf16x8 qf[4];
#pragma unroll
            for (int s4 = 0; s4 < 4; ++s4) qf[s4] = *(const GAS bf16x8*)(PX + (size_t)qrow * INW + h * 64 + 16 * s4 + 8 * hi);
            float ms = sink[h] * LOG2E, lsum = (hi == 0) ? 1.0f : 0.0f;
#pragma unroll
            for (int r = 0; r < 16; ++r) { O0[r] = 0.f; O1[r] = 0.f; }
            v4u kreg[2], vreg[2];
#define AT_LOADR(r0) do { const int r0_ = (r0); _Pragma("unroll") for (int i_ = 0; i_ < 2; ++i_) { const int p_ = tid + 512 * i_; \
                const GAS bf16* gp_ = PX + (size_t)(r0_ + (p_ >> 3)) * INW + OFF_K + kvh * 64 + (p_ & 7) * 8; kreg[i_] = *(const GAS v4u*)gp_; vreg[i_] = *(const GAS v4u*)(gp_ + (OFF_V - OFF_K)); } } while (0)
#define AT_WRITE(bufp) do { _Pragma("unroll") for (int i_ = 0; i_ < 2; ++i_) { const int p_ = tid + 512 * i_; const int key_ = p_ >> 3, ch_ = p_ & 7; \
                *(LAS v4u*)((bufp) + key_ * AT_KST + ch_ * 16) = kreg[i_]; \
                LAS unsigned short* vt_ = (LAS unsigned short*)((bufp) + AT_KB + (ch_ * 8) * AT_VST + key_ * 2); \
                vt_[0 * (AT_VST / 2)] = (unsigned short)(vreg[i_].x & 0xffffu); vt_[1 * (AT_VST / 2)] = (unsigned short)(vreg[i_].x >> 16); \
                vt_[2 * (AT_VST / 2)] = (unsigned short)(vreg[i_].y & 0xffffu); vt_[3 * (AT_VST / 2)] = (unsigned short)(vreg[i_].y >> 16); \
                vt_[4 * (AT_VST / 2)] = (unsigned short)(vreg[i_].z & 0xffffu); vt_[5 * (AT_VST / 2)] = (unsigned short)(vreg[i_].z >> 16); \
                vt_[6 * (AT_VST / 2)] = (unsigned short)(vreg[i_].w & 0xffffu); vt_[7 * (AT_VST / 2)] = (unsigned short)(vreg[i_].w >> 16); } } while (0)
            AT_LOADR(TX + b * CTXL);
            if (isx) {
                v4u k2[2], v2[2]; const int r0b = b * SEQ + (validB ? n + 1 : n) * 128;
#pragma unroll
                for (int i_ = 0; i_ < 2; ++i_) { const int p_ = tid + 512 * i_; const GAS bf16* gp_ = PX + (size_t)(r0b + (p_ >> 3)) * INW + OFF_K + kvh * 64 + (p_ & 7) * 8; k2[i_] = *(const GAS v4u*)gp_; v2[i_] = *(const GAS v4u*)(gp_ + (OFF_V - OFF_K)); }
                AT_WRITE(lds);
#pragma unroll
                for (int i_ = 0; i_ < 2; ++i_) { kreg[i_] = k2[i_]; vreg[i_] = v2[i_]; }
                AT_WRITE(lds + 2 * AT_BUF);
            } else AT_WRITE(lds);
            __syncthreads();
#pragma unroll 1
            for (int i = 0; i < nfull; ++i) {
                const bool hasn = (i + 1 < nfull) || isx;
                if (hasn) { const int r0n = (i == 0) ? (TX + b * CTXL + 128) : (i == 1) ? (b * SEQ + n * 128) : (b * SEQ + (validA ? n - 1 : n) * 128); AT_LOADR(r0n); }
                const int bo = (i & 1) * AT_BUF;
                int kofs[4], vofs[4];
#pragma unroll
                for (int mt = 0; mt < 4; ++mt) { kofs[mt] = bo + 32 * mt * AT_KST; vofs[mt] = bo + AT_KB + 64 * mt; }
                AT_TILE(4, );
                if (hasn) AT_WRITE(lds + ((i + 1) & 1) * AT_BUF);
                __syncthreads();
            }
            if (isx) {
                const int wq = w0 & 3;
                int kofs[5], vofs[5];
#pragma unroll
                for (int mt = 0; mt < 4; ++mt) { const int so = (mt < wq) ? 2 * AT_BUF : AT_BUF; kofs[mt] = so + 32 * mt * AT_KST; vofs[mt] = so + AT_KB + 64 * mt; }
                kofs[4] = 2 * AT_BUF + 32 * wq * AT_KST; vofs[4] = 2 * AT_BUF + AT_KB + 64 * wq;
#define AT_EDGE_MASK { int dq = ql - 4 * hi; asm volatile("" : "+v"(dq)); \
                    _Pragma("unroll") for (int mt = 0; mt < 4; ++mt) { \
                        const bool dead = (mt < wq) ? !validB : !validA; \
                        if (dead) { _Pragma("unroll") for (int r = 0; r < 16; ++r) S[mt][r] = -1.0e30f; } \
                        else if (mt == wq) { _Pragma("unroll") for (int r = 0; r < 16; ++r) { const int c = (r & 3) + 8 * (r >> 2); S[mt][r] = (c < dq) ? -1.0e30f : S[mt][r]; } } } \
                    if (!validB) { _Pragma("unroll") for (int r = 0; r < 16; ++r) S[4][r] = -1.0e30f; } \
                    else { _Pragma("unroll") for (int r = 0; r < 16; ++r) { const int c = (r & 3) + 8 * (r >> 2); S[4][r] = (c > dq) ? -1.0e30f : S[4][r]; } } }
                AT_TILE(5, AT_EDGE_MASK);
#undef AT_EDGE_MASK
                __syncthreads();
            }
#undef AT_LOADR
#undef AT_WRITE
            lsum = xor32_sum(lsum);
            const float inv = __builtin_amdgcn_rcpf(lsum); float ssq = 0.f;
#pragma unroll
            for (int r = 0; r < 16; ++r) { O0[r] *= inv; O1[r] *= inv; ssq += O0[r] * O0[r] + O1[r] * O1[r]; }
            ssq = xor32_sum(ssq);
            if (hi == 0) ssT[h * 128 + qi] = ssq;
            if (kvh == 0) { Oa[0] = O0; Oa[1] = O1; }
        }
        __syncthreads();
        const float tot = ssT[qi] + ssT[128 + qi] + ssT[256 + qi] + ssT[384 + qi];
        const float rstd = __builtin_amdgcn_rsqf(tot * (1.0f / 256.0f) + EPS);
        GAS bf16* orow = MIX + (size_t)qrow * D;
        const GAS float* gngo = gng; asm volatile("" : "+s"(gngo));
#pragma unroll
        for (int kv = 0; kv < 2; ++kv)
#pragma unroll
            for (int dt = 0; dt < 2; ++dt)
#pragma unroll
                for (int k4 = 0; k4 < 4; ++k4) { const int hh = kv * 2 + g, d = 32 * dt + 8 * k4 + 4 * hi; const f32x4 gg = *(const GAS f32x4*)(gngo + hh * 64 + d);
                    const f32x16& src = kv == 0 ? Oa[dt] : (dt == 0 ? O0 : O1);
                    v2u w; w.x = pk2(src[4 * k4 + 0] * rstd * gg.x, src[4 * k4 + 1] * rstd * gg.y); w.y = pk2(src[4 * k4 + 2] * rstd * gg.z, src[4 * k4 + 3] * rstd * gg.w);
                    *(GAS v2u*)(orow + hh * 64 + d) = w; }
        __syncthreads();
    }
}
#undef AT_TILE

#define MFMA16(a, b, c) __builtin_amdgcn_mfma_f32_16x16x32_bf16((a), (b), (c), 0, 0, 0)
constexpr int CV_HG = 0, CV_CV = 94 * 512, CV_Z = CV_CV + 64 * 512, CV_ZST = 528, CV_SS = CV_Z + 64 * CV_ZST;
__device__ __forceinline__ void conv_mfma(const GAS bf16* PX, GAS bf16* MIX, const GAS float* dww, const GAS float* dwb, const GAS float* lng, const GAS float* lnb, const GAS bf16* cpwT, const GAS float* gng, LAS unsigned char* lds, int nunits, const int w0_) {
    const int w0 = opq(w0_);
    const int tid = TIDX(w0), wave = w0, lane = tid & 63, fr = lane & 15, fq = lane >> 4;
    LAS unsigned char* hgb = lds + CV_HG; LAS unsigned char* cvb = lds + CV_CV; LAS unsigned char* zb = lds + CV_Z; LAS float* ssw = (LAS float*)(lds + CV_SS);
    const int cp = tid & 127, tg = tid >> 7;
    const int gd_ = gdim_(); int bx_ = bidx_() + 192; if (bx_ >= gd_) bx_ -= gd_;
    v2u ra[12], rg[12];
#define CV_LOAD(uu, i0, i1) do { int rb_, t0_, Ls_; if ((uu) < 1024) { rb_ = ((uu) >> 5) * SEQ; t0_ = ((uu) & 31) * 64; Ls_ = SEQ; } else { const int u2_ = (uu) - 1024; rb_ = TX + (u2_ >> 2) * CTXL; t0_ = (u2_ & 3) * 64; Ls_ = CTXL; } \
        _Pragma("unroll") for (int it = (i0); it < (i1); ++it) { const int idx = tid + 512 * it, tt = idx >> 6, c4 = (idx & 63) * 4, t = t0_ - 15 + tt; const bool ok = (tt < 94) && t >= 0 && t < Ls_; \
            const GAS bf16* rp = PX + (size_t)(rb_ + (ok ? t : t0_)) * INW + OFF_CONV + c4; ra[it] = *(const GAS v2u*)rp; rg[it] = *(const GAS v2u*)(rp + 256); } } while (0)
    if (bx_ < nunits) CV_LOAD(bx_, 0, 6);
    for (int u = bx_; u < nunits; u += gd_) {
        int rowbase, t0, Ls;
        if (u < 1024) { rowbase = (u >> 5) * SEQ; t0 = (u & 31) * 64; Ls = SEQ; } else { const int u2 = u - 1024; rowbase = TX + (u2 >> 2) * CTXL; t0 = (u2 & 3) * 64; Ls = CTXL; }
        CV_LOAD(u, 6, 12);
#pragma unroll
        for (int it = 0; it < 12; ++it) { const int idx = tid + 512 * it, tt = idx >> 6, c4 = (idx & 63) * 4, t = t0 - 15 + tt; const bool ok = (tt < 94) && t >= 0 && t < Ls;
            const v2u av = ok ? ra[it] : (v2u){0u, 0u}, gv = rg[it];
            v2u w; w.x = pk2(bflo(av.x) * sigmoidf_(bflo(gv.x)), bfhi(av.x) * sigmoidf_(bfhi(gv.x))); w.y = pk2(bflo(av.y) * sigmoidf_(bflo(gv.y)), bfhi(av.y) * sigmoidf_(bfhi(gv.y)));
            if (tt < 94) *(LAS v2u*)(hgb + (tt * 256 + c4) * 2) = w; }
        if (u + gd_ < nunits) CV_LOAD(u + gd_, 0, 6);
        f32x2 wreg[31];
        { const GAS float* dwwo = dww; asm volatile("" : "+s"(dwwo));
#pragma unroll
          for (int j = 0; j < 31; ++j) wreg[j] = *(const GAS f32x2*)(dwwo + j * 256 + 2 * cp); }
        __syncthreads();
        {
            const f32x2 bias = *(const GAS f32x2*)(dwb + 2 * cp);
#pragma unroll 1
            for (int hp8 = 0; hp8 < 2; ++hp8) { const int tb = tg * 16 + hp8 * 8; f32x2 a2[8];
#pragma unroll
                for (int tt = 0; tt < 8; ++tt) a2[tt] = bias;
                { f32x2 win[23];
#pragma unroll
                  for (int j = 0; j < 23; ++j) { const unsigned w = *(const LAS unsigned*)(hgb + ((tb + j) * 256 + 2 * cp) * 2); win[j] = (f32x2){bflo(w), bfhi(w)}; }
#pragma unroll
                  for (int tt = 0; tt < 8; ++tt)
#pragma unroll
                      for (int j = 0; j < 16; ++j) a2[tt] = a2[tt] + win[tt + j] * wreg[j]; }
                asm volatile("" ::: "memory"); __builtin_amdgcn_sched_barrier(0);
                { f32x2 win[22];
#pragma unroll
                  for (int j = 0; j < 22; ++j) { const unsigned w = *(const LAS unsigned*)(hgb + ((tb + 16 + j) * 256 + 2 * cp) * 2); win[j] = (f32x2){bflo(w), bfhi(w)}; }
#pragma unroll
                  for (int tt = 0; tt < 8; ++tt)
#pragma unroll
                      for (int j = 16; j < 31; ++j) a2[tt] = a2[tt] + win[tt + j - 16] * wreg[j]; }
#pragma unroll
                for (int tt = 0; tt < 8; ++tt) *(LAS unsigned*)(cvb + ((tb + tt) * 256 + 2 * cp) * 2) = pk2(a2[tt].x, a2[tt].y);
                asm volatile("" ::: "memory"); __builtin_amdgcn_sched_barrier(0); } }
        __syncthreads();
        bf16x8 wf[2][8];
#pragma unroll
        for (int nt = 0; nt < 2; ++nt)
#pragma unroll
            for (int s8 = 0; s8 < 8; ++s8) wf[nt][s8] = *(const GAS bf16x8*)(cpwT + (size_t)(32 * wave + 16 * nt + fr) * 256 + 32 * s8 + 8 * fq);
        { const f32x4 lg = *(const GAS f32x4*)(lng + lane * 4), lb = *(const GAS f32x4*)(lnb + lane * 4);
          for (int tt = wave; tt < 64; tt += 8) { const v2u raw = *(const LAS v2u*)(cvb + (tt * 256 + lane * 4) * 2); float v[4] = {bflo(raw.x), bfhi(raw.x), bflo(raw.y), bfhi(raw.y)};
            const float mean = wave_sum((v[0] + v[1]) + (v[2] + v[3])) * (1.0f / 256.0f); float s2 = 0.f;
#pragma unroll
            for (int j = 0; j < 4; ++j) { v[j] -= mean; s2 += v[j] * v[j]; }
            const float rstd = __builtin_amdgcn_rsqf(wave_sum(s2) * (1.0f / 256.0f) + EPS);
            float y[4] = {v[0] * rstd * lg.x + lb.x, v[1] * rstd * lg.y + lb.y, v[2] * rstd * lg.z + lb.z, v[3] * rstd * lg.w + lb.w};
#pragma unroll
            for (int j = 0; j < 4; ++j) y[j] = y[j] * sigmoidf_(y[j]);
            v2u w; w.x = pk2(y[0], y[1]); w.y = pk2(y[2], y[3]); *(LAS v2u*)(zb + tt * CV_ZST + lane * 8) = w; } }
        __syncthreads();
        f32x4 acc[2][4];
#pragma unroll
        for (int nt = 0; nt < 2; ++nt)
#pragma unroll
            for (int tt = 0; tt < 4; ++tt) acc[nt][tt] = (f32x4){0.f, 0.f, 0.f, 0.f};
#pragma unroll
        for (int s8 = 0; s8 < 8; ++s8) {
            bf16x8 zf[4];
#pragma unroll
            for (int tt = 0; tt < 4; ++tt) zf[tt] = *(const LAS bf16x8*)(zb + (16 * tt + fr) * CV_ZST + (32 * s8 + 8 * fq) * 2);
#pragma unroll
            for (int nt = 0; nt < 2; ++nt)
#pragma unroll
                for (int tt = 0; tt < 4; ++tt) acc[nt][tt] = MFMA16(wf[nt][s8], zf[tt], acc[nt][tt]);
        }
#pragma unroll
        for (int tt = 0; tt < 4; ++tt) { float ss = 0.f;
#pragma unroll
            for (int nt = 0; nt < 2; ++nt)
#pragma unroll
                for (int rg = 0; rg < 4; ++rg) ss += acc[nt][tt][rg] * acc[nt][tt][rg];
            ss = xor16_sum(ss); ss = xor32_sum(ss);
            if (fq == 0) ssw[wave * 64 + 16 * tt + fr] = ss; }
        __syncthreads();
#pragma unroll
        for (int tt = 0; tt < 4; ++tt) { const int tk = 16 * tt + fr; float tot = 0.f;
#pragma unroll
            for (int w8 = 0; w8 < 8; ++w8) tot += ssw[w8 * 64 + tk];
            const float rstd = __builtin_amdgcn_rsqf(tot * (1.0f / 256.0f) + EPS);
#pragma unroll
            for (int nt = 0; nt < 2; ++nt) { const int n0 = 32 * wave + 16 * nt + 4 * fq; const f32x4 gg = *(const GAS f32x4*)(gng + 256 + n0);
                v2u w; w.x = pk2(acc[nt][tt][0] * rstd * gg.x, acc[nt][tt][1] * rstd * gg.y); w.y = pk2(acc[nt][tt][2] * rstd * gg.z, acc[nt][tt][3] * rstd * gg.w);
                *(GAS v2u*)(MIX + (size_t)(rowbase + t0 + tk) * D + 256 + n0) = w; } }
        __syncthreads();
    }
#undef CV_LOAD
}

constexpr int GM_VST = 272, GM_SS = 256 * GM_VST;
__device__ __forceinline__ void gmlp_mfma(const GAS bf16* PX, GAS bf16* MIX, const GAS float* lng, const GAS float* lnb, const GAS bf16* gwsb, const GAS float* gbs, const GAS float* gng, LAS unsigned char* lds, int nunits, const int w0_) {
    const int w0 = opq(w0_);
    const int tid = TIDX(w0), wave = w0, lane = tid & 63, fr = lane & 15, fq = lane >> 4;
    LAS float* ssh = (LAS float*)(lds + GM_SS);
    const int hh = wave >> 1, mh = wave & 1;
    const int gd_ = gdim_(); int bx_ = bidx_() + 64; if (bx_ >= gd_) bx_ -= gd_;
    for (int u = bx_; u < nunits; u += gd_) {
        int rowbase;
        if (u < 512) rowbase = (u >> 4) * SEQ + (u & 15) * 128; else { const int u2 = u - 512; rowbase = TX + (u2 >> 1) * CTXL + (u2 & 1) * 128; }
        bf16x8 wfr[4][4];
#pragma unroll
        for (int s4 = 0; s4 < 4; ++s4)
#pragma unroll
            for (int mt = 0; mt < 4; ++mt) wfr[s4][mt] = *(const GAS bf16x8*)(gwsb + ((size_t)hh * 128 + 64 * mh + 16 * mt + fr) * 128 + 32 * s4 + 8 * fq);
        { const f32x4 lg = *(const GAS f32x4*)(lng + lane * 4), lb = *(const GAS f32x4*)(lnb + lane * 4);
          const int swz = (lane >> 1) & 3;
          v2u rawa[16];
#pragma unroll
          for (int q = 0; q < 16; ++q) rawa[q] = *(const GAS v2u*)(PX + (size_t)(rowbase + wave * 16 + q) * INW + OFF_GMLP + 256 + lane * 4);
#pragma unroll
          for (int tq = 0; tq < 4; ++tq) { const int tb = wave * 16 + 4 * tq; float o[4][4];
#pragma unroll
              for (int q = 0; q < 4; ++q) { const v2u rq = rawa[4 * tq + q];
                  float v[4] = {bflo(rq.x), bfhi(rq.x), bflo(rq.y), bfhi(rq.y)};
                  const float mean = wave_sum((v[0] + v[1]) + (v[2] + v[3])) * (1.0f / 256.0f); float s2 = 0.f;
#pragma unroll
                  for (int j = 0; j < 4; ++j) { v[j] -= mean; s2 += v[j] * v[j]; }
                  const float rstd = __builtin_amdgcn_rsqf(wave_sum(s2) * (1.0f / 256.0f) + EPS);
                  o[q][0] = v[0] * rstd * lg.x + lb.x; o[q][1] = v[1] * rstd * lg.y + lb.y; o[q][2] = v[2] * rstd * lg.z + lb.z; o[q][3] = v[3] * rstd * lg.w + lb.w; }
              LAS unsigned char* vt = lds + (lane * 4) * GM_VST + (((tb >> 3) ^ swz) << 4) + (tb & 7) * 2;
#pragma unroll
              for (int j = 0; j < 4; ++j) { v2u w; w.x = pk2(o[0][j], o[1][j]); w.y = pk2(o[2][j], o[3][j]); *(LAS v2u*)(vt + j * GM_VST) = w; } } }
        __syncthreads();
        f32x4 acc[4][4];
        v2u uraw[4][4];
#pragma unroll
        for (int mt = 0; mt < 4; ++mt)
#pragma unroll
            for (int nt = 0; nt < 4; ++nt) { acc[mt][nt] = (f32x4){0.f, 0.f, 0.f, 0.f};
                uraw[mt][nt] = *(const GAS v2u*)(PX + (size_t)(rowbase + 64 * mh + 16 * mt + fr) * INW + OFF_GMLP + 64 * hh + 4 * fq + 16 * nt); }
#pragma unroll
        for (int s4 = 0; s4 < 4; ++s4) {
            bf16x8 vf[4];
#pragma unroll
            for (int nt = 0; nt < 4; ++nt) vf[nt] = *(const LAS bf16x8*)(lds + (hh * 64 + 16 * nt + fr) * GM_VST + (((4 * s4 + fq) ^ (((nt & 1) << 1) | (fr >> 3))) << 4));
#pragma unroll
            for (int mt = 0; mt < 4; ++mt)
#pragma unroll
                for (int nt = 0; nt < 4; ++nt) acc[mt][nt] = MFMA16(vf[nt], wfr[s4][mt], acc[mt][nt]);
        }
#pragma unroll
        for (int mt = 0; mt < 4; ++mt) { const int p = 64 * mh + 16 * mt + fr; const float bsv = gbs[hh * 128 + p]; float ss = 0.f;
#pragma unroll
            for (int nt = 0; nt < 4; ++nt) { const v2u raw = uraw[mt][nt];
                acc[mt][nt][0] = bflo(raw.x) * (acc[mt][nt][0] + bsv); acc[mt][nt][1] = bfhi(raw.x) * (acc[mt][nt][1] + bsv);
                acc[mt][nt][2] = bflo(raw.y) * (acc[mt][nt][2] + bsv); acc[mt][nt][3] = bfhi(raw.y) * (acc[mt][nt][3] + bsv);
                ss += (acc[mt][nt][0] * acc[mt][nt][0] + acc[mt][nt][1] * acc[mt][nt][1]) + (acc[mt][nt][2] * acc[mt][nt][2] + acc[mt][nt][3] * acc[mt][nt][3]); }
            ss = xor16_sum(ss); ss = xor32_sum(ss);
            if (fq == 0) ssh[hh * 128 + p] = ss; }
        __syncthreads();
#pragma unroll
        for (int mt = 0; mt < 4; ++mt) { const int p = 64 * mh + 16 * mt + fr; const float tot = ssh[p] + ssh[128 + p] + ssh[256 + p] + ssh[384 + p];
            const float rstd = __builtin_amdgcn_rsqf(tot * (1.0f / 256.0f) + EPS);
#pragma unroll
            for (int nt = 0; nt < 4; ++nt) { const int c0 = 64 * hh + 16 * nt + 4 * fq; const f32x4 gg = *(const GAS f32x4*)(gng + 512 + c0);
                v2u w; w.x = pk2(acc[mt][nt][0] * rstd * gg.x, acc[mt][nt][1] * rstd * gg.y); w.y = pk2(acc[mt][nt][2] * rstd * gg.z, acc[mt][nt][3] * rstd * gg.w);
                *(GAS v2u*)(MIX + (size_t)(rowbase + p) * D + 512 + c0) = w; } }
        __syncthreads();
    }
}

constexpr int PL_HP = 0, PL_Y = 80 * 1024, PL_YST = 528, PL_SS = PL_Y + 64 * PL_YST;
template <int W>
__device__ __forceinline__ void pool_window(const LAS float* hp, LAS unsigned char* yb, int c, int half, int tbase, int Ls) {
    float win[48];
#pragma unroll
    for (int j = 0; j < 48; ++j) win[j] = hp[(half * 32 + j) * 256 + c];
    float S = 0.f;
#pragma unroll
    for (int j = 8 - W; j < 8 + W; ++j) S += win[j];
    if (tbase >= W && tbase + 31 + W <= Ls) {
#pragma unroll
        for (int i = 0; i < 32; ++i) { const float y = S * (1.0f / (2 * W)) - win[i + 8];
            *(LAS unsigned short*)(yb + (half * 32 + i) * PL_YST + c * 2) = (unsigned short)f2bf(y);
            if (i < 31) S += win[i + 8 + W] - win[i + 8 - W]; }
    } else {
#pragma unroll
    for (int i = 0; i < 32; ++i) { const int t = tbase + i; const int cnt = min(t + W, Ls) - max(t - W, 0);
        const float y = S * __builtin_amdgcn_rcpf((float)cnt) - win[i + 8];
        *(LAS unsigned short*)(yb + (half * 32 + i) * PL_YST + c * 2) = (unsigned short)f2bf(y);
        if (i < 31) S += win[i + 8 + W] - win[i + 8 - W]; }
    }
}
__device__ __forceinline__ void pool_mfma(const GAS bf16* PX, GAS bf16* MIX, const GAS bf16* pwT, const GAS float* pscale, const GAS float* gng, LAS unsigned char* lds, int nunits, const int w0_) {
    const int w0 = opq(w0_);
    const int tid = TIDX(w0), wave = w0, lane = tid & 63, fr = lane & 15, fq = lane >> 4;
    LAS float* hp = (LAS float*)(lds + PL_HP); LAS unsigned char* yb = lds + PL_Y; LAS float* ssw = (LAS float*)(lds + PL_SS);
    const int c = tid & 255, half = tid >> 8, gic = c >> 6;
    const int gi = wave >> 1, nh = wave & 1;
    const int gd_ = gdim_(); int bx_ = bidx_() + 64; if (bx_ >= gd_) bx_ -= gd_;
    v2u ra[10];
#define PL_LOAD(uu) do { int rb_, t0_, Ls_; if ((uu) < 1024) { rb_ = ((uu) >> 5) * SEQ; t0_ = ((uu) & 31) * 64; Ls_ = SEQ; } else { const int u2_ = (uu) - 1024; rb_ = TX + (u2_ >> 2) * CTXL; t0_ = (u2_ & 3) * 64; Ls_ = CTXL; } \
        _Pragma("unroll") for (int it = 0; it < 10; ++it) { const int idx = tid + 512 * it, tt = idx >> 6, c4 = (idx & 63) * 4, t = t0_ - 8 + tt; const bool ok = t >= 0 && t < Ls_; \
            ra[it] = *(const GAS v2u*)(PX + (size_t)(rb_ + (ok ? t : t0_)) * INW + OFF_POOL + c4); } } while (0)
    if (bx_ < nunits) PL_LOAD(bx_);
    for (int u = bx_; u < nunits; u += gd_) {
        int rowbase, t0, Ls;
        if (u < 1024) { rowbase = (u >> 5) * SEQ; t0 = (u & 31) * 64; Ls = SEQ; } else { const int u2 = u - 1024; rowbase = TX + (u2 >> 2) * CTXL; t0 = (u2 & 3) * 64; Ls = CTXL; }
        {
#pragma unroll
          for (int it = 0; it < 10; ++it) { const int idx = tid + 512 * it, tt = idx >> 6, c4 = (idx & 63) * 4, t = t0 - 8 + tt; const bool ok = t >= 0 && t < Ls;
              const v2u rv = ok ? ra[it] : (v2u){0u, 0u};
              *(LAS f32x4*)(hp + tt * 256 + c4) = (f32x4){bflo(rv.x), bfhi(rv.x), bflo(rv.y), bfhi(rv.y)}; } }
        if (u + gd_ < nunits) PL_LOAD(u + gd_);
        bf16x8 wf[2][2];
#pragma unroll
        for (int nt = 0; nt < 2; ++nt)
#pragma unroll
            for (int s2 = 0; s2 < 2; ++s2) wf[nt][s2] = *(const GAS bf16x8*)(pwT + ((size_t)gi * 64 + 32 * nh + 16 * nt + fr) * 64 + 32 * s2 + 8 * fq);
        __syncthreads();
        { const int tbase = t0 + half * 32;
          if (gic == 0) pool_window<1>(hp, yb, c, half, tbase, Ls); else if (gic == 1) pool_window<2>(hp, yb, c, half, tbase, Ls);
          else if (gic == 2) pool_window<4>(hp, yb, c, half, tbase, Ls); else pool_window<8>(hp, yb, c, half, tbase, Ls); }
        __syncthreads();
        f32x4 acc[2][4];
#pragma unroll
        for (int nt = 0; nt < 2; ++nt)
#pragma unroll
            for (int tt = 0; tt < 4; ++tt) acc[nt][tt] = (f32x4){0.f, 0.f, 0.f, 0.f};
#pragma unroll
        for (int s2 = 0; s2 < 2; ++s2) {
            bf16x8 yf[4];
#pragma unroll
            for (int tt = 0; tt < 4; ++tt) yf[tt] = *(const LAS bf16x8*)(yb + (16 * tt + fr) * PL_YST + (gi * 64 + 32 * s2 + 8 * fq) * 2);
#pragma unroll
            for (int nt = 0; nt < 2; ++nt)
#pragma unroll
                for (int tt = 0; tt < 4; ++tt) acc[nt][tt] = MFMA16(wf[nt][s2], yf[tt], acc[nt][tt]);
        }
#pragma unroll
        for (int nt = 0; nt < 2; ++nt) { const f32x4 ps = *(const GAS f32x4*)(pscale + 64 * gi + 32 * nh + 16 * nt + 4 * fq);
#pragma unroll
            for (int tt = 0; tt < 4; ++tt) { acc[nt][tt][0] *= ps.x; acc[nt][tt][1] *= ps.y; acc[nt][tt][2] *= ps.z; acc[nt][tt][3] *= ps.w; } }
#pragma unroll
        for (int tt = 0; tt < 4; ++tt) { float ss = 0.f;
#pragma unroll
            for (int nt = 0; nt < 2; ++nt)
#pragma unroll
                for (int rg = 0; rg < 4; ++rg) ss += acc[nt][tt][rg] * acc[nt][tt][rg];
            ss = xor16_sum(ss); ss = xor32_sum(ss);
            if (fq == 0) ssw[wave * 64 + 16 * tt + fr] = ss; }
        __syncthreads();
#pragma unroll
        for (int tt = 0; tt < 4; ++tt) { const int tk = 16 * tt + fr; float tot = 0.f;
#pragma unroll
            for (int w8 = 0; w8 < 8; ++w8) tot += ssw[w8 * 64 + tk];
            const float rstd = __builtin_amdgcn_rsqf(tot * (1.0f / 256.0f) + EPS);
#pragma unroll
            for (int nt = 0; nt < 2; ++nt) { const int n0 = 64 * gi + 32 * nh + 16 * nt + 4 * fq; const f32x4 gg = *(const GAS f32x4*)(gng + 768 + n0);
                v2u w; w.x = pk2(acc[nt][tt][0] * rstd * gg.x, acc[nt][tt][1] * rstd * gg.y); w.y = pk2(acc[nt][tt][2] * rstd * gg.z, acc[nt][tt][3] * rstd * gg.w);
                *(GAS v2u*)(MIX + (size_t)(rowbase + t0 + tk) * D + 768 + n0) = w; } }
        __syncthreads();
    }
#undef PL_LOAD
}

__device__ __forceinline__ unsigned long long ldptr(const volatile LAS unsigned long long* PT, int i) {
    const unsigned long long v = PT[i];
    const unsigned lo = __builtin_amdgcn_readfirstlane((unsigned)v), hi = __builtin_amdgcn_readfirstlane((unsigned)(v >> 32));
    return ((unsigned long long)hi << 32) | lo;
}
#define INP(i) ((const GAS float*)ldptr(PT, (i)))
#define OUTP() ((GAS float*)ldptr(PT, 30))
#define WSP() ((GAS unsigned char*)ldptr(PT, 31))

__global__ void __launch_bounds__(512, 2) __attribute__((amdgpu_waves_per_eu(2, 2))) fwd(Args args) {
    extern __shared__ __attribute__((aligned(16))) unsigned char lds_raw[];
    LAS unsigned char* lds = (LAS unsigned char*)lds_raw;
    volatile LAS unsigned* MISC = (volatile LAS unsigned*)(lds + MISC_OFF);
    volatile LAS unsigned long long* PT = (volatile LAS unsigned long long*)(lds + MISC_OFF + MO_PT);
#define PHASE_IDS() const int wave = opq(wave0); const int tid = TIDX(wave), lane = tid & 63; const int BX = bidx_(), G = gdim_(); (void)BX; const int gw = BX * 8 + wave, NGW = G * 8; (void)gw; (void)NGW; (void)lane
    const int lo = args.ph_lo, hi = args.ph_hi;
    const int wave0 = __builtin_amdgcn_readfirstlane((int)threadIdx.x >> 6);
    { const int tid = threadIdx.x;
      if (tid < 4) MISC[tid] = 0u;
      if (tid < 30) PT[tid] = (unsigned long long)args.in[tid];
      if (tid == 30) PT[30] = (unsigned long long)args.out;
      if (tid == 31) PT[31] = (unsigned long long)args.ws; }
    __syncthreads();
    XcdBarrier bar; bar.bar = (GAS unsigned*)(WSP() + WS_CTL) + CW_BAR; bar.x = 0; bar.st = MISC;
    if (hi - lo > 1) bar = xcd_barrier_post((GAS unsigned*)(WSP() + WS_CTL) + CW_BAR, MISC, wave0);
#ifndef PH_MASK
#define PH_MASK 0xFFFFFFFFu
#endif
#define IN(k) (((PH_MASK >> ((k) > 9 ? (k) - 9 : (k))) & 1u) && lo <= (k) && (k) < hi)
#define SEAM(k) do { if (IN(k) && IN((k) + 1)) xcd_barrier(bar, wave0); } while (0)

    if (IN(0)) {
            PHASE_IDS();
        GAS unsigned char* ws = WSP();
        {
            GAS bf16* WIN_T = (GAS bf16*)(ws + WS_WIN); GAS bf16* WOUT_T = (GAS bf16*)(ws + WS_WOUT); GAS unsigned char* W1_T = ws + WS_W1; GAS unsigned char* W2_T = ws + WS_W2;
            const GAS float* w_in = INP(I_WIN); const GAS float* w_out = INP(I_WOUT); const GAS float* w1 = INP(I_W1); const GAS float* w2 = INP(I_W2);
            LAS float* scr = (LAS float*)(lds + wave * 16384);
            for (int it = gw; it < 1024; it += NGW) {
                int r = it;
                { const int mi = r / 512; p0_transpose_item(w_out + (size_t)mi * 1024 * 1024, 1024, 1024, WOUT_T + (size_t)mi * 1024 * 1024, scr, r % 512, lane); }
            }
            {
                constexpr int NF = 49152 + 896; GAS unsigned char* WIN8_T = ws + WS_WIN;
                f32x4 la[16], lb[16];
                int r = gw + NGW / 2; if (r >= NGW) r -= NGW;
                P0Item ia = p0_f8_decode(r < NF ? r : 0, w1, w2, w_in, W1_T, W2_T, WIN8_T, lane), ib = ia;
                if (r < NF) p0_f8_load(ia, la);
#pragma unroll 1
                while (r < NF) {
                    int rn = r + NGW;
                    if (rn < NF) { ib = p0_f8_decode(rn, w1, w2, w_in, W1_T, W2_T, WIN8_T, lane); p0_f8_load(ib, lb); }
                    p0_f8_store(ia.dst, la);
                    r = rn; if (r >= NF) break;
                    rn = r + NGW;
                    if (rn < NF) { ia = p0_f8_decode(rn, w1, w2, w_in, W1_T, W2_T, WIN8_T, lane); p0_f8_load(ia, la); }
                    p0_f8_store(ib.dst, lb);
                    r = rn;
                }
            }
        }
        {
            GAS bf16* GWSB = (GAS bf16*)(ws + WS_GWSB); GAS bf16* CPWT = (GAS bf16*)(ws + WS_CPWT); GAS bf16* PWT = (GAS bf16*)(ws + WS_PWT);
            const GAS float* gws = INP(I_GWS); const GAS float* cpw = INP(I_CPW); const GAS float* plw = INP(I_POOLW);
            const int gt = BX * 512 + tid, GT = G * 512;
            for (int i = gt; i < 2 * 4 * 128 * 128; i += GT) GWSB[i] = (bf16)f2bf(gws[i]);
            for (int i = gt; i < 2 * 256 * 256; i += GT) { const int l2 = i >> 16, n = (i >> 8) & 255, c = i & 255; CPWT[i] = (bf16)f2bf(cpw[(size_t)l2 * 65536 + c * 256 + n]); }
            for (int i = gt; i < 2 * 4 * 64 * 64; i += GT) { const int lg = i >> 12, n = (i >> 6) & 63, k = i & 63; PWT[i] = (bf16)f2bf(plw[(size_t)lg * 4096 + k * 64 + n]); }
        }
        {
            GAS float* ROPE = (GAS float*)(ws + WS_ROPE);
            for (int idx = BX * 512 + tid; idx < 1024; idx += G * 512) { const int pos = idx >> 4, i = idx & 15;
                const float inv = powf(10000.0f, -(float)i / 16.0f); const float ang = (float)pos * inv; ROPE[idx] = cosf(ang); ROPE[1024 + idx] = sinf(ang); }
        }
        __syncthreads();
        {
            GAS float* MOD = (GAS float*)(ws + WS_MOD);
            const GAS float* cc = INP(I_C); const GAS float* cctx = INP(I_CCTX); const GAS float* adaw = INP(I_ADAW); const GAS float* adab = INP(I_ADAB);
            LAS float* sc = (LAS float*)lds;
            LAS float* scx = (LAS float*)(lds + MISC_OFF + MO_TMP);
            LAS float* red = (LAS float*)lds;
            const int fr = lane & 15, fk = lane >> 4;
            for (int item = BX; item < 256; item += G) {
                const int l = item >> 7, jb = (item & 127) * 48;
                const GAS float* aw = adaw + (size_t)l * 1024 * 6144 + jb;
                float bw[32][3];
                { const unsigned loff = (unsigned)(fk * 6144 + fr); const GAS float* awk = aw + (size_t)wave * 128 * 6144;
#pragma unroll
                  for (int st = 0; st < 32; ++st) { const GAS float* rowp = awk + (size_t)st * 4 * 6144;
#pragma unroll
                      for (int nt = 0; nt < 3; ++nt) bw[st][nt] = __builtin_nontemporal_load(rowp + loff + 16 * nt); } }
                __syncthreads();
                for (int idx = tid; idx < 33 * 1024; idx += 512) { const int bi = idx >> 10, k = idx & 1023; const float v = (bi < 32) ? cc[idx] : cctx[k]; const float sv = v * sigmoidf_(v);
                    if (bi < 32) sc[bi * 1024 + (k ^ ((bi & 7) << 2))] = sv; else scx[k] = sv; }
                __syncthreads();
                f32x4 dm[3][3];
#pragma unroll
                for (int mt = 0; mt < 3; ++mt)
#pragma unroll
                    for (int nt = 0; nt < 3; ++nt) dm[mt][nt] = (f32x4){0.f, 0.f, 0.f, 0.f};
#pragma unroll
                for (int st = 0; st < 32; ++st) { const int k = wave * 128 + 4 * st + fk;
                    const float a0 = sc[fr * 1024 + (k ^ ((fr & 7) << 2))], a1 = sc[(16 + fr) * 1024 + (k ^ ((fr & 7) << 2))];
                    const float ax = scx[k]; const float a2 = (fr == 0) ? ax : 0.f;
#pragma unroll
                    for (int nt = 0; nt < 3; ++nt) {
                        dm[0][nt] = __builtin_amdgcn_mfma_f32_16x16x4f32(a0, bw[st][nt], dm[0][nt], 0, 0, 0);
                        dm[1][nt] = __builtin_amdgcn_mfma_f32_16x16x4f32(a1, bw[st][nt], dm[1][nt], 0, 0, 0);
                        dm[2][nt] = __builtin_amdgcn_mfma_f32_16x16x4f32(a2, bw[st][nt], dm[2][nt], 0, 0, 0); } }
                __syncthreads();
#pragma unroll
                for (int mt = 0; mt < 3; ++mt)
#pragma unroll
                    for (int nt = 0; nt < 3; ++nt)
#pragma unroll
                        for (int r = 0; r < 4; ++r) red[(wave * 48 + 16 * mt + 4 * fk + r) * 48 + 16 * nt + fr] = dm[mt][nt][r];
                __syncthreads();
                for (int o = tid; o < 33 * 48; o += 512) { const int i = o / 48, c2 = o % 48; float sacc = adab[l * 6144 + jb + c2];
#pragma unroll
                    for (int k8 = 0; k8 < 8; ++k8) sacc += red[(k8 * 48 + i) * 48 + c2];
                    MOD[((size_t)l * 33 + i) * 6144 + jb + c2] = sacc; }
            }
            __syncthreads();
        }
    }
    SEAM(0);

#pragma unroll
    for (int l = 0; l < 2; ++l) {
        const int pb = 1 + 9 * l;
        const int ntok = (l == 0) ? TT : TX;
        if (IN(pb)) {
            PHASE_IDS();
            GAS unsigned char* ws = WSP(); GAS float* out = OUTP();
            const GAS float* MOD = (const GAS float*)(ws + WS_MOD); const GAS float* modl = MOD + (size_t)l * 33 * 6144;
            GAS float* CTXR = (GAS float*)(ws + WS_CTXR); GAS bf16* HX = (GAS bf16*)(ws + WS_HX); const GAS unsigned char* YB = ws + WS_R2; GAS bf16* XB = (GAS bf16*)(ws + WS_XB);
            const GAS int* SLOT = (const GAS int*)(ws + WS_ROUTE + RT_SLOT); const GAS float* GATE = (const GAS float*)(ws + WS_ROUTE + RT_GATE);
            const GAS float* g = INP(I_N1G) + l * D; const GAS float* xin = INP(I_X); const GAS float* cin = INP(I_CTX);
            for (int ra = gw; ra < TT; ra += 2 * NGW) {
                const int rb = (ra + NGW < TT) ? ra + NGW : ra;
                const bool isxa = ra < TX, isxb = rb < TX; const int bia = isxa ? (ra >> 11) : 32, bib = isxb ? (rb >> 11) : 32;
                f32x4 va[4], vb[4], h[4];
                if (l == 0) {
                    load_row<false>(isxa ? xin + (size_t)ra * D : cin + (size_t)(ra - TX) * D, ra, nullptr, nullptr, nullptr, nullptr, lane, va);
                    load_row<false>(isxb ? xin + (size_t)rb * D : cin + (size_t)(rb - TX) * D, rb, nullptr, nullptr, nullptr, nullptr, lane, vb);
                } else {
                    load_row2<!DBG_SKIP_MOE>(isxa ? (const GAS void*)(XB + (size_t)ra * D) : (const GAS void*)(CTXR + (size_t)(ra - TX) * D), isxa, isxb ? (const GAS void*)(XB + (size_t)rb * D) : (const GAS void*)(CTXR + (size_t)(rb - TX) * D), isxb, ra, rb, SLOT, GATE, YB,
                                             MOD + (size_t)(bia * 6 + 5) * D, MOD + (size_t)(bib * 6 + 5) * D, lane, va, vb);
                    if (isxa) st_row_bf16(XB + (size_t)ra * D, lane, va);
                    if (isxb && rb != ra) st_row_bf16(XB + (size_t)rb * D, lane, vb); }
                const float rsa = row_rstd(va), rsb = row_rstd(vb);
                mod_store_fp8(va, rsa, g, modl + (size_t)(bia * 6 + 1) * D, modl + (size_t)(bia * 6 + 0) * D, (GAS unsigned char*)HX + (size_t)ra * D, lane);
                mod_store_fp8(vb, rsb, g, modl + (size_t)(bib * 6 + 1) * D, modl + (size_t)(bib * 6 + 0) * D, (GAS unsigned char*)HX + (size_t)rb * D, lane);
            }
        }
        if (IN(pb)) {
            PHASE_IDS();
            GAS unsigned char* ws = WSP();
            const GAS float* modl = (const GAS float*)(ws + WS_MOD) + (size_t)l * 33 * 6144; const GAS float* g = INP(I_N2G) + l * D; const GAS float* rw = INP(I_RW) + (size_t)l * 1024 * 32; const GAS float* rb = INP(I_RB) + l * 32;
            GAS v4u* BMF = (GAS v4u*)(ws + WS_BMF) + (size_t)l * 33 * 32 * 2 * 64 * 2; GAS float* CVEC = (GAS float*)(ws + WS_CVEC) + l * 33 * 32;
            for (int idx = BX * 512 + tid; idx < 33 * 32 * 2 * 64; idx += G * 512) {
                const int lf = idx & 63, nt = (idx >> 6) & 1, s4 = (idx >> 7) & 31, bi = idx >> 12;
                const int e = 16 * nt + (lf & 15), k0 = 32 * s4 + 8 * (lf >> 4);
                const GAS float* scp = modl + (size_t)(bi * 6 + 4) * D;
                float v[8]; unsigned hb[8];
#pragma unroll
                for (int j = 0; j < 8; ++j) { v[j] = g[k0 + j] * (1.0f + scp[k0 + j]) * rw[(k0 + j) * 32 + e]; hb[j] = f2bf(v[j]); }
                v4u hw, lw;
                hw.x = hb[0] | (hb[1] << 16); hw.y = hb[2] | (hb[3] << 16); hw.z = hb[4] | (hb[5] << 16); hw.w = hb[6] | (hb[7] << 16);
                lw.x = pk2(v[0] - bflo(hb[0]), v[1] - bflo(hb[1])); lw.y = pk2(v[2] - bflo(hb[2]), v[3] - bflo(hb[3])); lw.z = pk2(v[4] - bflo(hb[4]), v[5] - bflo(hb[5])); lw.w = pk2(v[6] - bflo(hb[6]), v[7] - bflo(hb[7]));
                BMF[(size_t)idx * 2] = hw; BMF[(size_t)idx * 2 + 1] = lw;
            }
            for (int task = gw; task < 33 * 32; task += NGW) { const int bi = task >> 5, e = task & 31; const GAS float* shp = modl + (size_t)(bi * 6 + 3) * D; float a = 0.f;
                for (int k = lane; k < 1024; k += 64) a += shp[k] * rw[k * 32 + e];
                a = wave_sum(a); if (lane == 0) CVEC[task] = a + rb[e]; }
        }
        SEAM(pb);
        if (IN(pb + 1)) {
            const int BX = bidx_(), G = gdim_();
            GAS unsigned char* ws = WSP();
            ProbIn P{ws + WS_HX, ws + WS_WIN + (size_t)l * 1792 * 1024, (GAS bf16*)(ws + WS_R1), l, BX, G, (const GAS float*)(ws + WS_ROPE)};
            pg8::gemm_phase<ProbIn>(lds, P, wave0);
        }
        SEAM(pb + 1);
#ifndef MIXSEL
#define MIXSEL 15
#endif
        if (IN(pb + 3)) {
            const int BX = bidx_(), G = gdim_(); (void)BX; (void)G;
            if (MIXSEL == 0) { GAS v4u* mx = (GAS v4u*)(WSP() + WS_R1 + 252 * MiB); for (size_t i = (size_t)BX * 512 + TIDX(wave0); i < (size_t)TT * D / 8; i += (size_t)G * 512) mx[i] = (v4u){0u, 0u, 0u, 0u}; }
            if (MIXSEL & 1) { GAS unsigned char* ws = WSP(); attn_mfma((const GAS bf16*)(ws + WS_R1), (GAS bf16*)(ws + WS_R1 + 252 * MiB), INP(I_SINK) + l * 4, INP(I_GNG) + l * D, lds, l == 0 ? 576 : 512, wave0); }
            __syncthreads();
            if (MIXSEL & 2) { GAS unsigned char* ws = WSP(); conv_mfma((const GAS bf16*)(ws + WS_R1), (GAS bf16*)(ws + WS_R1 + 252 * MiB), INP(I_DWW) + l * 31 * 256, INP(I_DWB) + l * 256, INP(I_CLNG) + l * 256, INP(I_CLNB) + l * 256, (const GAS bf16*)(ws + WS_CPWT) + (size_t)l * 65536, INP(I_GNG) + l * D, lds, l == 0 ? 1152 : 1024, wave0); }
            __syncthreads();
            if (MIXSEL & 4) { GAS unsigned char* ws = WSP(); gmlp_mfma((const GAS bf16*)(ws + WS_R1), (GAS bf16*)(ws + WS_R1 + 252 * MiB), INP(I_GLNG) + l * 256, INP(I_GLNB) + l * 256, (const GAS bf16*)(ws + WS_GWSB) + (size_t)l * 4 * 128 * 128, INP(I_GBS) + l * 512, INP(I_GNG) + l * D, lds, l == 0 ? 576 : 512, wave0); }
            __syncthreads();
            if (MIXSEL & 8) { GAS unsigned char* ws = WSP(); pool_mfma((const GAS bf16*)(ws + WS_R1), (GAS bf16*)(ws + WS_R1 + 252 * MiB), (const GAS bf16*)(ws + WS_PWT) + (size_t)l * 4 * 64 * 64, INP(I_PSCALE) + l * 256, INP(I_GNG) + l * D, lds, l == 0 ? 1152 : 1024, wave0); }
            __syncthreads();
        }
        SEAM(pb + 3);
        if (IN(pb + 4)) {
            const int BX = bidx_(), G = gdim_();
            GAS unsigned char* ws = WSP(); GAS float* out = OUTP();
            ProbOut P{(const GAS bf16*)(ws + WS_R1 + 252 * MiB), (const GAS bf16*)(ws + WS_WOUT) + (size_t)l * 1024 * 1024, INP(I_X), INP(I_CTX), (GAS bf16*)(ws + WS_XB), (GAS float*)(ws + WS_CTXR), (const GAS float*)(ws + WS_MOD) + (size_t)l * 33 * 6144, l == 0 ? 288 : 256, l, BX, G};
            pg8::gemm_phase<ProbOut>(lds, P, wave0);
        }
        SEAM(pb + 4);
        if (IN(pb + 5)) {
            PHASE_IDS();
            GAS unsigned char* ws = WSP(); const GAS bf16* XB = (const GAS bf16*)(ws + WS_XB);
            const GAS float* modl = (const GAS float*)(ws + WS_MOD) + (size_t)l * 33 * 6144; const GAS float* CTXR = (const GAS float*)(ws + WS_CTXR); GAS unsigned char* HX8 = ws + WS_HX;
            GAS int* TOPI = (GAS int*)(ws + WS_ROUTE + RT_TOPI); GAS float* GATE = (GAS float*)(ws + WS_ROUTE + RT_GATE); GAS int* LPOS = (GAS int*)(ws + WS_ROUTE + RT_LPOS); GAS int* WVCNT = (GAS int*)(ws + WS_ROUTE + RT_WVCNT);
            const GAS v4u* BMF = (const GAS v4u*)(ws + WS_BMF) + (size_t)l * 33 * 32 * 2 * 64 * 2; const GAS float* CVEC = (const GAS float*)(ws + WS_CVEC) + l * 33 * 32;
            const GAS float* g = INP(I_N2G) + l * D;
            const int tpw = ntok / G, ntile = tpw / 16;
            const int tok = lane & 15, kq = lane >> 4;
            int cnt = 0;
            const int xpw = TX / G, cpw = (ntok - TX) / G, nxt_ = xpw / 16;
            const int bi0 = (BX * xpw) >> 11;
            { const GAS v4u* src = BMF + (size_t)bi0 * 4096 * 2;
#pragma unroll 4
              for (int i = 0; i < 8; ++i) { const int idx = tid + 512 * i; const v4u vh = src[idx * 2], vl = src[idx * 2 + 1]; *(LAS v4u*)(lds + idx * 16) = vh; *(LAS v4u*)(lds + 65536 + idx * 16) = vl; } }
            LAS float* gsl = (LAS float*)(lds + MISC_OFF + MO_TMP); LAS float* s0l = gsl + 1024;
            { const GAS float* scp0 = modl + (size_t)(bi0 * 6 + 4) * D; const GAS float* shp0 = modl + (size_t)(bi0 * 6 + 3) * D;
              for (int idx = tid; idx < 1024; idx += 512) { gsl[idx] = g[idx] * (scp0[idx] + 1.0f); s0l[idx] = shp0[idx]; } }
            __syncthreads();
            for (int ti_ = 0; ; ++ti_) { const int tile = n2_tile(wave, ti_, ntile); if (tile < 0) break;
                const int r0 = (tile < nxt_) ? (BX * xpw + tile * 16) : (TX + BX * cpw + (tile - nxt_) * 16); const bool isx = r0 < TX; const int bi = isx ? (r0 >> 11) : 32;
                const GAS float* xr = CTXR + (size_t)(isx ? 0 : (r0 - TX)) * D;
                const GAS bf16* xrb = XB + (size_t)(isx ? r0 : 0) * D;
                f32x4 acc0 = (f32x4){0.f, 0.f, 0.f, 0.f}, acc1 = (f32x4){0.f, 0.f, 0.f, 0.f}, accq = (f32x4){0.f, 0.f, 0.f, 0.f}; float ssp = 0.f;
                const bool onepass = isx && bi == bi0;
                if (onepass) {
                    const GAS bf16* xp = xrb + (unsigned)(tok * D + 8 * kq);
                    v4u hws[32];
#pragma unroll
                    for (int s4 = 0; s4 < 32; ++s4) hws[s4] = *(const GAS v4u*)(xp + 32 * s4);
#pragma unroll
                    for (int s4 = 0; s4 < 32; ++s4) { const bf16x8 xh = __builtin_bit_cast(bf16x8, hws[s4]); accq = __builtin_amdgcn_mfma_f32_16x16x32_bf16(xh, xh, accq, 0, 0, 0); }
                    float rl;
                    { const int tr = tok & 3; const float dv = tr == 0 ? accq[0] : tr == 1 ? accq[1] : tr == 2 ? accq[2] : accq[3];
                      float sq = (kq == (tok >> 2)) ? dv : 0.f; sq = xor16_sum(sq); sq = xor32_sum(sq); rl = __builtin_amdgcn_rsqf(sq * (1.0f / D) + EPS); }
#pragma unroll
                    for (int s4 = 0; s4 < 32; ++s4) {
                        const v4u hw = hws[s4];
                        const bf16x8 xh = __builtin_bit_cast(bf16x8, hw);
                        const LAS unsigned char* lb = lds + ((s4 * 2) * 64 + lane) * 16;
                        const v4u b0h = *(const LAS v4u*)lb, b1h = *(const LAS v4u*)(lb + 1024), b0l = *(const LAS v4u*)(lb + 65536), b1l = *(const LAS v4u*)(lb + 65536 + 1024);
                        acc0 = __builtin_amdgcn_mfma_f32_16x16x32_bf16(xh, __builtin_bit_cast(bf16x8, b0h), acc0, 0, 0, 0);
                        acc0 = __builtin_amdgcn_mfma_f32_16x16x32_bf16(xh, __builtin_bit_cast(bf16x8, b0l), acc0, 0, 0, 0);
                        acc1 = __builtin_amdgcn_mfma_f32_16x16x32_bf16(xh, __builtin_bit_cast(bf16x8, b1h), acc1, 0, 0, 0);
                        acc1 = __builtin_amdgcn_mfma_f32_16x16x32_bf16(xh, __builtin_bit_cast(bf16x8, b1l), acc1, 0, 0, 0);
                        const int k0 = 32 * s4 + 8 * kq;
                        const f32x4 gA = *(const LAS f32x4*)(gsl + k0) * rl, gB = *(const LAS f32x4*)(gsl + k0 + 4) * rl, sA = *(const LAS f32x4*)(s0l + k0), sB = *(const LAS f32x4*)(s0l + k0 + 4);
                        const f32x4 va = (f32x4){bflo(hw.x), bfhi(hw.x), bflo(hw.y), bfhi(hw.y)}, vb = (f32x4){bflo(hw.z), bfhi(hw.z), bflo(hw.w), bfhi(hw.w)};
                        const f32x4 ha = va * gA + sA, hb = vb * gB + sB;
                        v2u o; o.x = pk4_fp8(ha.x, ha.y, ha.z, ha.w); o.y = pk4_fp8(hb.x, hb.y, hb.z, hb.w);
                        *(GAS v2u*)(HX8 + (unsigned)((r0 + tok) * D + k0)) = o;
                    }
                } else if (isx) {
                    int lo_ = lane; asm volatile("" : "+v"(lo_)); const int tok = lo_ & 15, kq = lo_ >> 4;
                    const GAS bf16* xp = xrb + (size_t)tok * D + 8 * kq; const GAS v4u* bp = BMF + (size_t)bi * 32 * 2 * 64 * 2 + lo_ * 2;
#pragma unroll 8
                    for (int s4 = 0; s4 < 32; ++s4) {
                        const v4u hw = *(const GAS v4u*)(xp + 32 * s4);
                        const bf16x8 xh = __builtin_bit_cast(bf16x8, hw);
                        accq = __builtin_amdgcn_mfma_f32_16x16x32_bf16(xh, xh, accq, 0, 0, 0);
                        const v4u b0h = bp[(s4 * 2 + 0) * 128], b0l = bp[(s4 * 2 + 0) * 128 + 1], b1h = bp[(s4 * 2 + 1) * 128], b1l = bp[(s4 * 2 + 1) * 128 + 1];
                        acc0 = __builtin_amdgcn_mfma_f32_16x16x32_bf16(xh, __builtin_bit_cast(bf16x8, b0h), acc0, 0, 0, 0);
                        acc0 = __builtin_amdgcn_mfma_f32_16x16x32_bf16(xh, __builtin_bit_cast(bf16x8, b0l), acc0, 0, 0, 0);
                        acc1 = __builtin_amdgcn_mfma_f32_16x16x32_bf16(xh, __builtin_bit_cast(bf16x8, b1h), acc1, 0, 0, 0);
                        acc1 = __builtin_amdgcn_mfma_f32_16x16x32_bf16(xh, __builtin_bit_cast(bf16x8, b1l), acc1, 0, 0, 0);
                    }
                } else {
                int lo_ = lane; asm volatile("" : "+v"(lo_)); const int tok = lo_ & 15, kq = lo_ >> 4;
                const GAS float* xp = xr + (size_t)tok * D + 8 * kq; const GAS v4u* bp = BMF + (size_t)bi * 32 * 2 * 64 * 2 + lo_ * 2;
#define N2_CTX_STEP(B0H, B0L, B1H, B1L) { \
                    const f32x4 xa = *(const GAS f32x4*)(xp + 32 * s4), xb = *(const GAS f32x4*)(xp + 32 * s4 + 4); \
                    ssp += (xa.x * xa.x + xa.y * xa.y) + (xa.z * xa.z + xa.w * xa.w) + (xb.x * xb.x + xb.y * xb.y) + (xb.z * xb.z + xb.w * xb.w); \
                    v4u hw; hw.x = cvt_pk_bf16(xa.x, xa.y); hw.y = cvt_pk_bf16(xa.z, xa.w); hw.z = cvt_pk_bf16(xb.x, xb.y); hw.w = cvt_pk_bf16(xb.z, xb.w); \
                    v4u lw; lw.x = cvt_pk_bf16(xa.x - bflo(hw.x), xa.y - bfhi(hw.x)); lw.y = cvt_pk_bf16(xa.z - bflo(hw.y), xa.w - bfhi(hw.y)); \
                    lw.z = cvt_pk_bf16(xb.x - bflo(hw.z), xb.y - bfhi(hw.z)); lw.w = cvt_pk_bf16(xb.z - bflo(hw.w), xb.w - bfhi(hw.w)); \
                    const bf16x8 xh = __builtin_bit_cast(bf16x8, hw), xl = __builtin_bit_cast(bf16x8, lw); \
                    const v4u b0h = (B0H), b0l = (B0L), b1h = (B1H), b1l = (B1L); \
                    acc0 = __builtin_amdgcn_mfma_f32_16x16x32_bf16(xh, __builtin_bit_cast(bf16x8, b0h), acc0, 0, 0, 0); \
                    acc0 = __builtin_amdgcn_mfma_f32_16x16x32_bf16(xl, __builtin_bit_cast(bf16x8, b0h), acc0, 0, 0, 0); \
                    acc0 = __builtin_amdgcn_mfma_f32_16x16x32_bf16(xh, __builtin_bit_cast(bf16x8, b0l), acc0, 0, 0, 0); \
                    acc1 = __builtin_amdgcn_mfma_f32_16x16x32_bf16(xh, __builtin_bit_cast(bf16x8, b1h), acc1, 0, 0, 0); \
                    acc1 = __builtin_amdgcn_mfma_f32_16x16x32_bf16(xl, __builtin_bit_cast(bf16x8, b1h), acc1, 0, 0, 0); \
                    acc1 = __builtin_amdgcn_mfma_f32_16x16x32_bf16(xh, __builtin_bit_cast(bf16x8, b1l), acc1, 0, 0, 0); }
                if (bi == bi0) {
#pragma unroll 4
                    for (int s4 = 0; s4 < 32; ++s4) { const LAS unsigned char* lb = lds + ((s4 * 2) * 64 + lo_) * 16;
                        N2_CTX_STEP(*(const LAS v4u*)lb, *(const LAS v4u*)(lb + 65536), *(const LAS v4u*)(lb + 1024), *(const LAS v4u*)(lb + 65536 + 1024)) }
                } else {
#pragma unroll 8
                    for (int s4 = 0; s4 < 32; ++s4) N2_CTX_STEP(bp[(s4 * 2 + 0) * 128], bp[(s4 * 2 + 0) * 128 + 1], bp[(s4 * 2 + 1) * 128], bp[(s4 * 2 + 1) * 128 + 1])
                }
#undef N2_CTX_STEP
                }
                if (isx) { const int tr = tok & 3; const float dv = tr == 0 ? accq[0] : tr == 1 ? accq[1] : tr == 2 ? accq[2] : accq[3];
                    ssp = (kq == (tok >> 2)) ? dv : 0.f; }
                ssp = xor16_sum(ssp); ssp = xor32_sum(ssp);
                const float rstd_l = __builtin_amdgcn_rsqf(ssp * (1.0f / D) + EPS);
                const float cv0 = CVEC[bi * 32 + tok], cv1 = CVEC[bi * 32 + 16 + tok];
                float lg0[4], lg1[4];
#pragma unroll
                for (int rg = 0; rg < 4; ++rg) { const float rs = __int_as_float(__builtin_amdgcn_ds_bpermute((4 * kq + rg) << 2, __float_as_int(rstd_l))); lg0[rg] = acc0[rg] * rs + cv0; lg1[rg] = acc1[rg] * rs + cv1; }
                int ti[4][4]; float tv[4][4];
#pragma unroll
                for (int k = 0; k < 4; ++k)
#pragma unroll
                    for (int rg = 0; rg < 4; ++rg) {
                        float bv = fmaxf(lg0[rg], lg1[rg]);
                        bv = fmaxf(bv, dpp_f<0xB1>(bv)); bv = fmaxf(bv, dpp_f<0x4E>(bv)); bv = fmaxf(bv, dpp_f<0x124>(bv)); bv = fmaxf(bv, dpp_f<0x128>(bv));
                        int bidx = (lg0[rg] == bv) ? tok : ((lg1[rg] == bv) ? 16 + tok : 64);
                        bidx = min(bidx, dpp_i<0xB1>(bidx)); bidx = min(bidx, dpp_i<0x4E>(bidx)); bidx = min(bidx, dpp_i<0x124>(bidx)); bidx = min(bidx, dpp_i<0x128>(bidx));
                        tv[rg][k] = bv; ti[rg][k] = bidx; if (bidx == tok) lg0[rg] = -3.0e38f; if (bidx == 16 + tok) lg1[rg] = -3.0e38f;
                    }
#pragma unroll
                for (int rg = 0; rg < 4; ++rg) { float ex[4], sum = 0.f;
#pragma unroll
                    for (int k = 0; k < 4; ++k) { ex[k] = __expf(tv[rg][k] - tv[rg][0]); sum += ex[k]; }
                    const float isum = __builtin_amdgcn_rcpf(sum); const int r = r0 + 4 * kq + rg;
#pragma unroll
                    for (int k = 0; k < 4; ++k) if (tok == k) { TOPI[r * 4 + k] = ti[rg][k]; GATE[r * 4 + k] = ex[k] * isum; } }
                int mypos = 0;
                { int myE;
                  { const int rsel = (lane >> 2) & 3, ksel = lane & 3; int er[4];
#pragma unroll
                    for (int rg = 0; rg < 4; ++rg) er[rg] = ksel == 0 ? ti[rg][0] : ksel == 1 ? ti[rg][1] : ksel == 2 ? ti[rg][2] : ti[rg][3];
                    myE = rsel == 0 ? er[0] : rsel == 1 ? er[1] : rsel == 2 ? er[2] : er[3]; }
#pragma unroll
                  for (int e = 0; e < 32; ++e) {
                      const unsigned long long mk = __builtin_amdgcn_ballot_w64(myE == e);
                      const int rank = (int)__builtin_amdgcn_mbcnt_hi((unsigned)(mk >> 32), __builtin_amdgcn_mbcnt_lo((unsigned)mk, 0u));
                      const int base = __builtin_amdgcn_readlane(cnt, e);
                      if (myE == e) mypos = base + rank;
                      if (lane == e) cnt += (int)__builtin_popcountll(mk); } }
                LPOS[r0 * 4 + lane] = mypos;
                { const GAS float* scp = modl + (size_t)(bi * 6 + 4) * D; const GAS float* shp = modl + (size_t)(bi * 6 + 3) * D;
                  if (onepass) {
                  } else if (isx) {
                      int lane_o = lane; asm volatile("" : "+v"(lane_o));
#define lane lane_o
                      f32x4 gs[4], s0[4];
#pragma unroll
                      for (int j = 0; j < 4; ++j) { const f32x4 g4 = ((const GAS f32x4*)g)[lane * 4 + j], s1 = ((const GAS f32x4*)scp)[lane * 4 + j] + 1.0f; s0[j] = ((const GAS f32x4*)shp)[lane * 4 + j]; gs[j] = g4 * s1; }
                      v4u xr2[4][2], xr3[4][2];
#define N2_LD(BUF, r4) do { _Pragma("unroll") for (int q = 0; q < 4; ++q) _Pragma("unroll") for (int i = 0; i < 2; ++i) BUF[q][i] = __builtin_nontemporal_load((const GAS v4u*)(xrb + (size_t)((r4) + q) * D) + lane * 2 + i); } while (0)
#define N2_ROW(rowi, WSRC) do { const float rs = __int_as_float(__builtin_amdgcn_readlane(__float_as_int(rstd_l), (rowi))); v4u o; \
                      { const v4u w = WSRC[0]; const f32x4 va = (f32x4){bflo(w.x), bfhi(w.x), bflo(w.y), bfhi(w.y)}, vb = (f32x4){bflo(w.z), bfhi(w.z), bflo(w.w), bfhi(w.w)}; \
                        const f32x4 ha = va * (gs[0] * rs) + s0[0], hb = vb * (gs[1] * rs) + s0[1]; o.x = pk4_fp8(ha.x, ha.y, ha.z, ha.w); o.y = pk4_fp8(hb.x, hb.y, hb.z, hb.w); } \
                      { const v4u w = WSRC[1]; const f32x4 va = (f32x4){bflo(w.x), bfhi(w.x), bflo(w.y), bfhi(w.y)}, vb = (f32x4){bflo(w.z), bfhi(w.z), bflo(w.w), bfhi(w.w)}; \
                        const f32x4 ha = va * (gs[2] * rs) + s0[2], hb = vb * (gs[3] * rs) + s0[3]; o.z = pk4_fp8(ha.x, ha.y, ha.z, ha.w); o.w = pk4_fp8(hb.x, hb.y, hb.z, hb.w); } \
                      ((GAS v4u*)(HX8 + (size_t)(r0 + (rowi)) * D))[lane] = o; } while (0)
                      N2_LD(xr2, 0); N2_LD(xr3, 4);  N2_ROW(0, xr2[0]);  N2_ROW(1, xr2[1]);  N2_ROW(2, xr2[2]);   N2_ROW(3, xr2[3]);
                      N2_LD(xr2, 8);  N2_ROW(4, xr3[0]);  N2_ROW(5, xr3[1]);  N2_ROW(6, xr3[2]);   N2_ROW(7, xr3[3]);
                      N2_LD(xr3, 12); N2_ROW(8, xr2[0]);  N2_ROW(9, xr2[1]);  N2_ROW(10, xr2[2]);  N2_ROW(11, xr2[3]);
                      N2_ROW(12, xr3[0]); N2_ROW(13, xr3[1]); N2_ROW(14, xr3[2]); N2_ROW(15, xr3[3]);
#undef N2_ROW
#undef N2_LD
#undef lane
                  } else {
                  int lane_o = lane; asm volatile("" : "+v"(lane_o));
#define lane lane_o
                  f32x4 gg[4], s1[4], s0[4];
#pragma unroll
                  for (int j = 0; j < 4; ++j) { gg[j] = ((const GAS f32x4*)g)[lane + 64 * j]; s1[j] = ((const GAS f32x4*)scp)[lane + 64 * j] + 1.0f; s0[j] = ((const GAS f32x4*)shp)[lane + 64 * j]; gg[j] = gg[j] * s1[j]; }
                  for (int tt = 0; tt < 16; tt += 4) { f32x4 v[4][4];
#pragma unroll
                      for (int q = 0; q < 4; ++q) ld_row_any((const GAS void*)(xr + (size_t)(tt + q) * D), false, lane, v[q]);
#pragma unroll
                      for (int q = 0; q < 4; ++q) { const float rs = __int_as_float(__builtin_amdgcn_readlane(__float_as_int(rstd_l), tt + q)); GAS unsigned* dst = (GAS unsigned*)(HX8 + (size_t)(r0 + tt + q) * D);
#pragma unroll
                          for (int j = 0; j < 4; ++j) { const f32x4 hh = (v[q][j] * rs) * gg[j] + s0[j]; dst[lane + 64 * j] = pk4_fp8(hh.x, hh.y, hh.z, hh.w); } } }
#undef lane
                  }
                }
            }
            if (lane < 32) WVCNT[gw * 32 + lane] = cnt;
            __syncthreads();
        }
        SEAM(pb + 5);
        if (IN(pb + 6)) {
            PHASE_IDS();
            GAS unsigned char* ws = WSP();
            GAS int* ROWTOK = (GAS int*)(ws + WS_ROUTE + RT_ROWTOK);
            const GAS int* TOPI = (const GAS int*)(ws + WS_ROUTE + RT_TOPI); const GAS int* LPOS = (const GAS int*)(ws + WS_ROUTE + RT_LPOS); GAS int* SLOT = (GAS int*)(ws + WS_ROUTE + RT_SLOT); const GAS int* WVCNT = (const GAS int*)(ws + WS_ROUTE + RT_WVCNT);
            GAS int* META = (GAS int*)(ws + WS_META);
            LAS int* tmp = (LAS int*)(lds + MISC_OFF + MO_TMP);
            const int e = tid & 31, part = tid >> 5;
            { int tot = 0, pre = 0; const int lim = BX * 8;
              for (int idx = part * (NGW / 16); idx < (part + 1) * (NGW / 16); ++idx) { const int cval = WVCNT[idx * 32 + e]; tot += cval; if (idx < lim) pre += cval; }
              tmp[part * 32 + e] = tot; tmp[512 + part * 32 + e] = pre; }
            __syncthreads();
            if (tid < 32) { int tot = 0, pre = 0;
#pragma unroll
                for (int p = 0; p < 16; ++p) { tot += tmp[p * 32 + tid]; pre += tmp[512 + p * 32 + tid]; }
                tmp[1024 + tid] = tot; tmp[1056 + tid] = pre; }
            __syncthreads();
            if (tid < 33) { int ps = 0; for (int e2 = 0; e2 < tid; ++e2) ps += ((tmp[1024 + e2] + 255) >> 8) << 8; tmp[1088 + tid] = ps;
                if (BX == 0) META[l * 64 + tid] = ps; }
            __syncthreads();
            const int tpw = ntok / G;
            int basew = 0;
            if (lane < 32) { basew = tmp[1056 + lane]; for (int w2 = 0; w2 < wave; ++w2) basew += WVCNT[(BX * 8 + w2) * 32 + lane]; }
            const int xpw = TX / G, cpw = (ntok - TX) / G, nxt_ = xpw / 16;
            for (int ti_ = 0; ; ++ti_) { const int tile = n2_tile(wave, ti_, tpw / 16); if (tile < 0) break; const int r = (tile < nxt_) ? (BX * xpw + tile * 16) : (TX + BX * cpw + (tile - nxt_) * 16);
                const int ee = TOPI[r * 4 + lane], lp = LPOS[r * 4 + lane];
                const int bw = __builtin_amdgcn_ds_bpermute(ee << 2, basew); const int slot = tmp[1088 + ee] + bw + lp;
                SLOT[r * 4 + lane] = slot; ROWTOK[slot] = r + (lane >> 2); }
            if (BX < 32) { const int ee = BX; const int s0 = tmp[1088 + ee] + tmp[1024 + ee], s1 = tmp[1088 + ee + 1]; for (int sidx = s0 + tid; sidx < s1; sidx += 512) ROWTOK[sidx] = 0; }
            __syncthreads();
        }
        SEAM(pb + 6);
        if (IN(pb + 7) || IN(pb + 8)) {
            PHASE_IDS();
            LAS int* PS = (LAS int*)(lds + MISC_OFF + MO_PS); LAS unsigned char* tile_e = (LAS unsigned char*)(lds + MISC_OFF + MO_TILEE);
            { const GAS int* META = (const GAS int*)(WSP() + WS_META); if (tid < 33) PS[tid] = META[l * 64 + tid]; }
            __syncthreads();
            const int NT = PS[32] >> 8;
            for (int rt = tid; rt < NT; rt += 512) { int ee = 0; for (int e2 = 1; e2 < 32; ++e2) ee += (PS[e2] <= rt * 256) ? 1 : 0; tile_e[rt] = (unsigned char)ee; }
            __syncthreads();
            if (IN(pb + 7)) {
                GAS unsigned char* ws = WSP();
                Prob1 P{(const GAS int*)(ws + WS_ROUTE + RT_ROWTOK), ws + WS_HX, ws + WS_W1 + (size_t)l * 32 * 2048 * 1024, INP(I_B1) + (size_t)l * 32 * 2048, ws + WS_R1, tile_e, NT, BX, G};
                pg8::gemm_phase<Prob1>(lds, P, wave0);
            }
            SEAM(pb + 7);
            if (IN(pb + 8)) {
                GAS unsigned char* ws = WSP();
                Prob2 P{ws + WS_R1, ws + WS_W2 + (size_t)l * 32 * 1024 * 1024, INP(I_B2) + (size_t)l * 32 * 1024, ws + WS_R2, tile_e, NT, BX, G};
                pg8::gemm_phase<Prob2>(lds, P, wave0);
            }
        }
        SEAM(pb + 8);
    }

#if DBG_CHECK
    if (lo <= 19 && 19 < hi) {
        PHASE_IDS();
        GAS unsigned char* ws = WSP();
        const GAS bf16* HX = (const GAS bf16*)(ws + WS_HX); const GAS unsigned char* YB = ws + WS_R2;
        const GAS int* TOPI = (const GAS int*)(ws + WS_ROUTE + RT_TOPI); const GAS int* SLOT = (const GAS int*)(ws + WS_ROUTE + RT_SLOT); const GAS float* GATE = (const GAS float*)(ws + WS_ROUTE + RT_GATE);
        GAS unsigned* dbgw = (GAS unsigned*)(ws + WS_CTL) + 64;
        LAS float* hl = (LAS float*)lds; LAS float* al = hl + 1024; LAS float* yl = al + 1024; LAS float* red = yl + 1024;
        const int t = BX * 251 + 3;
        hl[tid] = bf1(HX[(size_t)t * D + tid]); hl[tid + 512] = bf1(HX[(size_t)t * D + tid + 512]); yl[tid] = 0.f; yl[tid + 512] = 0.f;
        __syncthreads();
#if DBG_CHECK == 1
        for (int k = 0; k < 4; ++k) {
            const int e = TOPI[t * 4 + k]; const float gt = GATE[t * 4 + k];
            const GAS float* w1e = INP(I_W1) + ((size_t)(32 + e)) * 1024 * 2048; const GAS float* b1e = INP(I_B1) + (size_t)(32 + e) * 2048;
            const GAS float* w2e = INP(I_W2) + ((size_t)(32 + e)) * 1024 * 1024; const GAS float* b2e = INP(I_B2) + (size_t)(32 + e) * 1024;
            float a0 = 0.f, a1 = 0.f, a2 = 0.f, a3 = 0.f;
            for (int kk = 0; kk < 1024; ++kk) { const float hv = hl[kk]; const GAS float* wr_ = w1e + (size_t)kk * 2048 + tid; a0 += hv * wr_[0]; a1 += hv * wr_[512]; a2 += hv * wr_[1024]; a3 += hv * wr_[1536]; }
            { float gl = fminf(a0 + b1e[tid], 7.f), ln = fminf(fmaxf(a2 + b1e[1024 + tid], -7.f), 7.f); al[tid] = gl * sigmoidf_(1.702f * gl) * (ln + 1.f);
              gl = fminf(a1 + b1e[512 + tid], 7.f); ln = fminf(fmaxf(a3 + b1e[1536 + tid], -7.f), 7.f); al[tid + 512] = gl * sigmoidf_(1.702f * gl) * (ln + 1.f); }
            __syncthreads();
            float c0 = 0.f, c1 = 0.f;
            for (int j = 0; j < 1024; ++j) { const float av = al[j]; c0 += av * w2e[(size_t)j * 1024 + tid]; c1 += av * w2e[(size_t)j * 1024 + tid + 512]; }
            yl[tid] += gt * (c0 + b2e[tid]); yl[tid + 512] += gt * (c1 + b2e[tid + 512]);
            __syncthreads();
        }
        float dsum = 0.f, rsum = 0.f;
#pragma unroll
        for (int q = 0; q < 2; ++q) { const int n = tid + 512 * q; float yp = 0.f;
            for (int k = 0; k < 4; ++k) yp += GATE[t * 4 + k] * bf1(YB[(size_t)SLOT[t * 4 + k] * D + n]);
            const float df = yp - yl[n]; dsum += df * df; rsum += yl[n] * yl[n]; }
        dsum = wave_sum(dsum); rsum = wave_sum(rsum);
        if (lane == 0) { red[wave] = dsum; red[8 + wave] = rsum; }
        __syncthreads();
        if (tid == 0) { float a = 0.f, b = 0.f; for (int w = 0; w < 8; ++w) { a += red[w]; b += red[8 + w]; }
            const float rel = sqrtf(a / fmaxf(b, 1e-20f)); atomicMax(dbgw, __builtin_bit_cast(unsigned, rel)); }
#else
        {
            const GAS float* rw = INP(I_RW) + (size_t)1 * 1024 * 32; const GAS float* rb = INP(I_RB) + 32;
            const int e = tid & 31, part = tid >> 5; float a = 0.f;
            for (int kk = part * 64; kk < part * 64 + 64; ++kk) a += hl[kk] * rw[kk * 32 + e];
            red[part * 32 + e] = a;
            __syncthreads();
            if (tid == 0) { float lg[32]; for (int e2 = 0; e2 < 32; ++e2) { float sacc = rb[e2]; for (int p = 0; p < 16; ++p) sacc += red[p * 32 + e2]; al[e2] = sacc; }
                int mism = 0;
                for (int k = 0; k < 4; ++k) { int best = 0; float bv = -3e38f; for (int e2 = 0; e2 < 32; ++e2) if (al[e2] > bv) { bv = al[e2]; best = e2; } al[best] = -3e38f;
                    bool found = false; for (int k2 = 0; k2 < 4; ++k2) found |= (TOPI[t * 4 + k2] == best); if (!found) mism++; }
                (void)lg; atomicAdd(dbgw, (unsigned)mism); }
        }
#endif
    }
    if (lo <= 20 && 20 < hi) {
        GAS float* out = OUTP(); const GAS unsigned* dbgw = (const GAS unsigned*)(WSP() + WS_CTL) + 64;
        const unsigned wv = *dbgw;
#if DBG_CHECK == 1
        const float metric = __builtin_bit_cast(float, wv);
#else
        const float metric = (float)wv / 1024.0f;
#endif
        const float V = sqrtf((float)TX * (float)D * 1000.0f * metric);
        for (size_t i = (size_t)BX * 512 + TIDX(wave0); i < (size_t)TX * D; i += (size_t)G * 512) out[i] = (i == 0) ? V : 0.f;
    }
#else
    if (IN(19)) {
            PHASE_IDS();
        GAS unsigned char* ws = WSP(); GAS float* out = OUTP();
        const GAS float* MOD = (const GAS float*)(ws + WS_MOD); const GAS unsigned char* YB = ws + WS_R2; const GAS bf16* XB = (const GAS bf16*)(ws + WS_XB);
        const GAS int* SLOT = (const GAS int*)(ws + WS_ROUTE + RT_SLOT); const GAS float* GATE = (const GAS float*)(ws + WS_ROUTE + RT_GATE);
        const GAS float* g = INP(I_FNG);
        for (int ra = gw; ra < TX; ra += 2 * NGW) { const int rb = (ra + NGW < TX) ? ra + NGW : ra; const int bia = ra >> 11, bib = rb >> 11;
            f32x4 va[4], vb[4];
            load_row2<!DBG_SKIP_MOE>(XB + (size_t)ra * D, true, XB + (size_t)rb * D, true, ra, rb, SLOT, GATE, YB, MOD + (size_t)((33 + bia) * 6 + 5) * D, MOD + (size_t)((33 + bib) * 6 + 5) * D, lane, va, vb);
            const float rsa = row_rstd(va), rsb = row_rstd(vb);
#pragma unroll
            for (int j = 0; j < 4; ++j) { const f32x4 gg = ((const GAS f32x4*)g)[lane + 64 * j]; __builtin_nontemporal_store(va[j] * rsa * gg, (GAS f32x4*)(out + (size_t)ra * D) + lane + 64 * j); if (rb != ra) __builtin_nontemporal_store(vb[j] * rsb * gg, (GAS f32x4*)(out + (size_t)rb * D) + lane + 64 * j); } }
    }
#endif
#undef IN
#undef SEAM
}

extern "C" void kernel_launch(void* const* d_in, const int* in_sizes, int n_in, void* d_out, int out_size, void* d_ws, size_t ws_size, hipStream_t stream) {
    static int grid = 0;
    if (grid == 0) {
        if (n_in != 30 || in_sizes[0] != TX * D || out_size != TX * D || ws_size < WS_END) { fprintf(stderr, "kernel_launch: unexpected problem (n_in %d, in0 %d, out %d, ws %zu); nothing launched\n", n_in, n_in > 0 ? in_sizes[0] : -1, out_size, ws_size); grid = -1; return; }
        int dev = 0, cus = 0;
        if (hipGetDevice(&dev) != hipSuccess || hipDeviceGetAttribute(&cus, hipDeviceAttributeMultiprocessorCount, dev) != hipSuccess) { grid = -1; return; }
        if (hipFuncSetAttribute((const void*)fwd, hipFuncAttributeMaxDynamicSharedMemorySize, LDS_BYTES) != hipSuccess) { fprintf(stderr, "kernel_launch: hipFuncSetAttribute failed\n"); grid = -1; return; }
        int per_cu = 0;
        if (hipOccupancyMaxActiveBlocksPerMultiprocessor(&per_cu, (const void*)fwd, 512, LDS_BYTES) != hipSuccess || per_cu < 1) fprintf(stderr, "kernel_launch: occupancy query says %d\n", per_cu);
        (void)hipGetLastError();
        grid = (cus >= 256) ? 256 : -1;
        if (grid < 0) { fprintf(stderr, "kernel_launch: needs 256 CUs, device has %d\n", cus); return; }
    }
    if (grid < 0) return;
    if (hipMemsetAsync((char*)d_ws + WS_CTL, 0, CTL_ZERO_BYTES, stream) != hipSuccess) return;
    Args a{};
    for (int i = 0; i < 30; ++i) a.in[i] = (const float*)d_in[i];
    a.out = (float*)d_out; a.ws = (unsigned char*)d_ws;
#if MK_LAUNCH_PER_PHASE
    for (int p = 0; p < NPHASE; ++p) { a.ph_lo = p; a.ph_hi = p + 1; hipLaunchKernelGGL(fwd, dim3(grid), dim3(512), LDS_BYTES, stream, a); }
#else
    a.ph_lo = 0; a.ph_hi = NPHASE;
    hipLaunchKernelGGL(fwd, dim3(grid), dim3(512), LDS_BYTES, stream, a);
#endif
}
```
